# Optimizing an MI355X kernel written in HIP

```python
import jax, jax.numpy as jnp
from jax import lax
import numpy as np

D_MODEL = 1024
BATCH = 1
SEQ = 16384
DEPTH = 2
DEC_BATCH = 32
DEC_SEQ = 1
PAST_LEN = 16384
PAGE_SIZE = 128

PLE_DIM = 256
D_FF = 2816
RMS_EPS = 1e-6
NEG_BIG = -1e30
MIN_F = 1e-30
A_HEADS = 8
A_HEAD_DIM = 64
A_CONFIGS = ((128, 1), (512, 4), (2048, 16))
A_MAX_WINDOW = 2048
B_HEADS = 4
B_KEY_DIM = 128
B_VAL_DIM = 64
C_HEADS = 4
C_KEY_DIM = 32
C_VAL_DIM = 64
C_GATE_RANK = 16
C_GATE_TEMP = 16.0
CHUNK = 64

A_WIDTH = A_HEADS * A_HEAD_DIM
B_WIDTH = B_HEADS * B_VAL_DIM
C_WIDTH = C_HEADS * C_VAL_DIM
D_MIX = A_WIDTH + B_WIDTH + C_WIDTH
PROJ_SIZES = (A_WIDTH, A_WIDTH, A_WIDTH,
              B_HEADS * B_KEY_DIM, B_HEADS * B_KEY_DIM, B_WIDTH, B_WIDTH,
              C_HEADS * C_KEY_DIM, C_HEADS * C_KEY_DIM, C_WIDTH, C_GATE_RANK, C_WIDTH)
PROJ_WIDTH = sum(PROJ_SIZES)

kernel_name = "hybrid_dilated_hgrn2_gla_decoder_step"


def rms_norm(x, g):
    xf = x.astype(jnp.float32)
    y = xf * lax.rsqrt(jnp.mean(xf * xf, axis=-1, keepdims=True) + RMS_EPS)
    return (y * g.astype(jnp.float32)).astype(x.dtype)


def swiglu(x, wg, wu, wd):
    return (jax.nn.silu(x @ wg) * (x @ wu)) @ wd


def alibi_slopes():
    return 2.0 ** (-8.0 * jnp.arange(1, A_HEADS + 1, dtype=jnp.float32) / A_HEADS)


def split_projection(z):
    cuts = [int(c) for c in np.cumsum(PROJ_SIZES)[:-1]]
    return jnp.split(z, cuts, axis=-1)


def dilated_attn_prompt(q, k, v, window, dil, slopes):
    b, t, h, e = q.shape
    sub = window // dil
    blk = sub
    span = dil * blk
    t_pad = -(-t // span) * span
    pad = ((0, 0), (0, t_pad - t), (0, 0), (0, 0))
    q, k, v = jnp.pad(q, pad), jnp.pad(k, pad), jnp.pad(v, pad)
    nb = t_pad // span
    shp = (b, nb, blk, dil, h, e)
    qb, kb, vb = q.reshape(shp), k.reshape(shp), v.reshape(shp)

    def with_prev(a):
        prev = jnp.pad(a, ((0, 0), (1, 0), (0, 0), (0, 0), (0, 0), (0, 0)))[:, :-1]
        return jnp.concatenate([prev, a], axis=2)

    kk, vv = with_prev(kb), with_prev(vb)
    s = jnp.einsum('bnqrhe,bnkrhe->bnrhqk', qb, kk).astype(jnp.float32)
    qi = jnp.arange(blk)[:, None]
    ki = jnp.arange(2 * blk)[None, :]
    j = qi + blk - ki
    band = (j >= 0) & (j <= sub)
    key_sub = jnp.arange(nb)[:, None, None] * blk + ki[None] - blk
    valid = band[None] & (key_sub >= 0)
    bias = -slopes[:, None, None] * (j * dil).astype(jnp.float32)[None]
    s = jnp.where(valid[None, :, None, None], s + bias, NEG_BIG)
    mx = jnp.max(s, axis=-1, keepdims=True)
    p = jnp.exp(s - mx)
    den = jnp.sum(p, axis=-1, keepdims=True)
    o = jnp.einsum('bnrhqk,bnkrhe->bnqrhe', p / den, vv.astype(jnp.float32))
    lse = (mx + jnp.log(den))[..., 0]
    o = o.reshape(b, t_pad, h, e)[:, :t]
    lse = jnp.transpose(lse, (0, 1, 4, 2, 3)).reshape(b, t_pad, h)[:, :t]
    return o, lse


def dilated_attn_sample(q, k_all, v_all, n_past, window, dil, slopes):
    s_len = q.shape[1]
    sub = window // dil
    jj = jnp.arange(sub + 1)
    idx = n_past + jnp.arange(s_len)[:, None] - jj[None] * dil
    valid = idx >= 0
    idx = jnp.maximum(idx, 0)
    kg = k_all[:, idx]
    vg = v_all[:, idx]
    sc = jnp.einsum('bqhe,bqjhe->bqhj', q, kg).astype(jnp.float32)
    sc = sc - slopes[:, None] * (jj * dil).astype(jnp.float32)[None]
    sc = jnp.where(valid[None, :, None, :], sc, NEG_BIG)
    mx = jnp.max(sc, axis=-1, keepdims=True)
    p = jnp.exp(sc - mx)
    den = jnp.sum(p, axis=-1, keepdims=True)
    o = jnp.einsum('bqhj,bqjhe->bqhe', p / den, vg.astype(jnp.float32))
    lse = (mx + jnp.log(den))[..., 0]
    return o, lse


def merge_by_denominator(outs, lses):
    w = jax.nn.softmax(jnp.stack(lses, axis=0), axis=0)
    return jnp.einsum('cbth,cbthe->bthe', w, jnp.stack(outs, axis=0))


def gated_linear_recurrence(q, k, v, log_f, s0):
    b, t, h, dk = q.shape
    dv = v.shape[-1]
    c = min(CHUNK, t)
    t_pad = -(-t // c) * c
    nc = t_pad // c

    def chunks(a):
        a = jnp.pad(a.astype(jnp.float32), ((0, 0), (0, t_pad - t), (0, 0), (0, 0)))
        return jnp.moveaxis(a.reshape(b, nc, c, h, a.shape[-1]), 1, 0)

    causal = jnp.tril(jnp.ones((c, c), dtype=bool))

    def step(state, inp):
        qc, kc, vc, gc = inp
        g_cum = jnp.cumsum(gc, axis=1)
        diff = g_cum[:, :, None] - g_cum[:, None, :]
        decay = jnp.exp(jnp.where(causal[None, :, :, None, None], diff, NEG_BIG))
        att = jnp.einsum('bthk,btshk->bths', qc, decay * kc[:, None])
        o = (jnp.einsum('bths,bshv->bthv', att, vc)
             + jnp.einsum('bthk,bhkv->bthv', qc * jnp.exp(g_cum), state))
        g_last = g_cum[:, -1]
        new_state = (jnp.exp(g_last)[..., None] * state
                     + jnp.einsum('bshk,bshv->bhkv', kc * jnp.exp(g_last[:, None] - g_cum), vc))
        return new_state, o

    s_fin, o = lax.scan(step, s0.astype(jnp.float32),
                        (chunks(q), chunks(k), chunks(v), chunks(log_f)))
    o = jnp.moveaxis(o, 0, 1).reshape(b, t_pad, h, dv)[:, :t]
    return o.astype(v.dtype), s_fin


def mixing(hn, w_in, lb, b_norm, c_w_gate, c_gate_bias, c_norm, w_out, k_past, v_past, b_state0, c_state0):
    bsz, t, _ = hn.shape
    aq, ak, av, bq, bf, bi, bg, cq, ck, cv, clr, cg = split_projection(hn @ w_in)

    def heads(a, n):
        return a.reshape(bsz, t, n, -1)

    aq = heads(aq, A_HEADS) * (A_HEAD_DIM ** -0.5)
    ak = heads(ak, A_HEADS)
    av = heads(av, A_HEADS)
    slopes = alibi_slopes()
    if k_past is None:
        res = [dilated_attn_prompt(aq, ak, av, w, d, slopes) for (w, d) in A_CONFIGS]
    else:
        k_all = jnp.concatenate([k_past.astype(ak.dtype), ak], axis=1)
        v_all = jnp.concatenate([v_past.astype(av.dtype), av], axis=1)
        n_past = k_past.shape[1]
        res = [dilated_attn_sample(aq, k_all, v_all, n_past, w, d, slopes) for (w, d) in A_CONFIGS]
    o_a = merge_by_denominator([r[0] for r in res], [r[1] for r in res])
    o_a = o_a.reshape(bsz, t, A_WIDTH).astype(hn.dtype)

    z = heads(bf, B_HEADS).astype(jnp.float32)
    f_b = lb + (1.0 - lb) * jax.nn.sigmoid(z)
    log_f = jnp.log(jnp.maximum(f_b, MIN_F))
    k_b = 1.0 - f_b
    q_b = jax.nn.silu(heads(bq, B_HEADS))
    i_b = heads(bi, B_HEADS)
    o_b, s_b = gated_linear_recurrence(q_b, k_b, i_b, log_f, b_state0)
    o_b = rms_norm(o_b, b_norm.reshape(B_HEADS, B_VAL_DIM)) * jax.nn.sigmoid(heads(bg, B_HEADS))

    q_c = heads(cq, C_HEADS) * (C_KEY_DIM ** -0.5)
    k_c = heads(ck, C_HEADS)
    v_c = heads(cv, C_HEADS)
    g_c = jax.nn.log_sigmoid((clr @ c_w_gate + c_gate_bias).astype(jnp.float32)) / C_GATE_TEMP
    o_c, s_c = gated_linear_recurrence(q_c, k_c, v_c, heads(g_c, C_HEADS), c_state0)
    o_c = rms_norm(o_c, c_norm.reshape(C_HEADS, C_VAL_DIM)) * jax.nn.silu(heads(cg, C_HEADS))

    mixed = jnp.concatenate([o_a, o_b.reshape(bsz, t, B_WIDTH), o_c.reshape(bsz, t, C_WIDTH)], axis=-1)
    return mixed @ w_out, ak, av, s_b, s_c


def run_trunk(x, p, prm, lb_all, k_cache, v_cache, s_b_in, s_c_in):
    bsz, t, _ = x.shape
    h = x
    k_rows, v_rows, sb_out, sc_out = [], [], [], []
    for i in range(DEPTH):
        h = h + 0.5 * swiglu(rms_norm(h, prm['ffn1_norm'][i]), prm['ffn1_w_gate'][i],
                             prm['ffn1_w_up'][i], prm['ffn1_w_down'][i])
        if k_cache is None:
            k_past, v_past = None, None
            sb0 = jnp.zeros((bsz, B_HEADS, B_KEY_DIM, B_VAL_DIM), jnp.float32)
            sc0 = jnp.zeros((bsz, C_HEADS, C_KEY_DIM, C_VAL_DIM), jnp.float32)
        else:
            k_past, v_past, sb0, sc0 = k_cache[i], v_cache[i], s_b_in[i], s_c_in[i]
        mixed, ak, av, sb, sc = mixing(rms_norm(h, prm['mix_norm'][i]), prm['w_in'][i], lb_all[i],
                                       prm['b_out_norm'][i], prm['c_w_gate'][i], prm['c_gate_bias'][i],
                                       prm['c_out_norm'][i], prm['w_out'][i], k_past, v_past, sb0, sc0)
        h = h + mixed
        h = h + 0.5 * swiglu(rms_norm(h, prm['ffn2_norm'][i]), prm['ffn2_w_gate'][i],
                             prm['ffn2_w_up'][i], prm['ffn2_w_down'][i])
        hn = rms_norm(h, prm['ple_norm'][i])
        h = h + jax.nn.sigmoid(hn @ prm['ple_w_gate'][i]) * (p[i].astype(h.dtype) @ prm['ple_w_proj'][i])
        if k_cache is None:
            keep = min(A_MAX_WINDOW, t)
            ak, av = ak[:, t - keep:], av[:, t - keep:]
        k_rows.append(ak)
        v_rows.append(av)
        sb_out.append(sb)
        sc_out.append(sc)
    y = rms_norm(h, prm['final_norm'])
    return y, jnp.stack(k_rows), jnp.stack(v_rows), jnp.stack(sb_out), jnp.stack(sc_out)


def setup_inputs(seed: int = 0) -> dict:
    key = jax.random.key(seed)
    keys = list(jax.random.split(key, 40))

    def nrm(shape, scale):
        return scale * jax.random.normal(keys.pop(), shape, jnp.float32)

    n_buf = min(A_MAX_WINDOW, PAST_LEN)
    L = DEPTH
    return {
        'x_prompt': nrm((BATCH, SEQ, D_MODEL), 1.0),
        'x_sample': nrm((DEC_BATCH, DEC_SEQ, D_MODEL), 1.0),
        'cache_k_a': nrm((L, DEC_BATCH, n_buf, A_HEADS, A_HEAD_DIM), 1.0),
        'cache_v_a': nrm((L, DEC_BATCH, n_buf, A_HEADS, A_HEAD_DIM), 1.0),
        'state_b': nrm((L, DEC_BATCH, B_HEADS, B_KEY_DIM, B_VAL_DIM), 0.5),
        'state_c': nrm((L, DEC_BATCH, C_HEADS, C_KEY_DIM, C_VAL_DIM), 0.5),
        'p_prompt': nrm((L, BATCH, SEQ, PLE_DIM), 1.0),
        'p_sample': nrm((L, DEC_BATCH, DEC_SEQ, PLE_DIM), 1.0),
        'ffn1_norm': 1.0 + nrm((L, D_MODEL), 0.02),
        'ffn1_w_gate': nrm((L, D_MODEL, D_FF), D_MODEL ** -0.5),
        'ffn1_w_up': nrm((L, D_MODEL, D_FF), D_MODEL ** -0.5),
        'ffn1_w_down': nrm((L, D_FF, D_MODEL), D_FF ** -0.5),
        'mix_norm': 1.0 + nrm((L, D_MODEL), 0.02),
        'w_in': nrm((L, D_MODEL, PROJ_WIDTH), D_MODEL ** -0.5),
        'lb_logits': nrm((L, B_HEADS, B_KEY_DIM), 1.0),
        'b_out_norm': 1.0 + nrm((L, B_WIDTH), 0.02),
        'c_w_gate': nrm((L, C_GATE_RANK, C_HEADS * C_KEY_DIM), C_GATE_RANK ** -0.5),
        'c_gate_bias': nrm((L, C_HEADS * C_KEY_DIM), 0.1),
        'c_out_norm': 1.0 + nrm((L, C_WIDTH), 0.02),
        'w_out': nrm((L, D_MIX, D_MODEL), D_MIX ** -0.5),
        'ffn2_norm': 1.0 + nrm((L, D_MODEL), 0.02),
        'ffn2_w_gate': nrm((L, D_MODEL, D_FF), D_MODEL ** -0.5),
        'ffn2_w_up': nrm((L, D_MODEL, D_FF), D_MODEL ** -0.5),
        'ffn2_w_down': nrm((L, D_FF, D_MODEL), D_FF ** -0.5),
        'ple_norm': 1.0 + nrm((L, D_MODEL), 0.02),
        'ple_w_gate': nrm((L, D_MODEL, D_MODEL), D_MODEL ** -0.5),
        'ple_w_proj': nrm((L, PLE_DIM, D_MODEL), PLE_DIM ** -0.5),
        'final_norm': 1.0 + nrm((D_MODEL,), 0.02),
    }


def reference(x_prompt, x_sample, cache_k_a, cache_v_a, state_b, state_c, p_prompt, p_sample,
              ffn1_norm, ffn1_w_gate, ffn1_w_up, ffn1_w_down, mix_norm, w_in, lb_logits, b_out_norm,
              c_w_gate, c_gate_bias, c_out_norm, w_out, ffn2_norm, ffn2_w_gate, ffn2_w_up, ffn2_w_down,
              ple_norm, ple_w_gate, ple_w_proj, final_norm):
    prm = dict(ffn1_norm=ffn1_norm, ffn1_w_gate=ffn1_w_gate, ffn1_w_up=ffn1_w_up, ffn1_w_down=ffn1_w_down,
               mix_norm=mix_norm, w_in=w_in, b_out_norm=b_out_norm, c_w_gate=c_w_gate,
               c_gate_bias=c_gate_bias, c_out_norm=c_out_norm, w_out=w_out, ffn2_norm=ffn2_norm,
               ffn2_w_gate=ffn2_w_gate, ffn2_w_up=ffn2_w_up, ffn2_w_down=ffn2_w_down, ple_norm=ple_norm,
               ple_w_gate=ple_w_gate, ple_w_proj=ple_w_proj, final_norm=final_norm)
    sm = jax.nn.softmax(lb_logits.astype(jnp.float32), axis=0)
    lb_all = jnp.maximum(jnp.cumsum(sm, axis=0) - sm[0], 0.0)
    y_prompt, k_a_p, v_a_p, s_b_p, s_c_p = run_trunk(x_prompt, p_prompt, prm, lb_all, None, None, None, None)
    y_sample, k_a_s, v_a_s, s_b_s, s_c_s = run_trunk(x_sample, p_sample, prm, lb_all,
                                                     cache_k_a, cache_v_a, state_b, state_c)
    return (y_prompt, y_sample, k_a_p, v_a_p, s_b_p, s_c_p, k_a_s, v_a_s, s_b_s, s_c_s)
```

```cpp
#include <hip/hip_runtime.h>
#include <hip/hip_cooperative_groups.h>
#include <cstdio>
#include <cstdint>
namespace cg = cooperative_groups;
namespace pg8 {
#define PG8_LAS __attribute__((address_space(3)))
typedef unsigned short bf16_t;
typedef short bf16x8 __attribute__((ext_vector_type(8)));
typedef float f32x4 __attribute__((ext_vector_type(4)));
typedef unsigned u32x4 __attribute__((ext_vector_type(4)));
constexpr int BM = 256, BK = 64, HALF = 128, HTB = HALF * BK * 2  , STAGE_BYTES = 8 * HTB, NXCD = 8, WGM = 8;

__host__ __device__ __forceinline__ int lds_byte(int r, int c) { const int st = (r >> 4) * 2 + (c >> 5), rr = r & 15, cc = c & 31, ob = rr * 64 + cc * 2; return st * 1024 + (ob ^ (((ob >> 9) & 1) << 5)); }
__host__ __device__ __forceinline__ void stage_rc(int b, int& R, int& C) { const int st = b / 1024, sb = b % 1024, swz = sb ^ (((sb >> 9) & 1) << 5); R = (st >> 1) * 16 + swz / 64; C = (st & 1) * 32 + (swz % 64) / 2; }
__host__ __device__ __forceinline__ int perm32(int rho) { const int n = rho >> 4, i = rho & 15; return 8 * (i >> 2) + 4 * n + (i & 3); }

struct Unit { int pm, pn; };
struct Gemm { const bf16_t* A; const bf16_t* Bt; int M, N, K; };

struct StaticOrder {
    int nM, nN, nwg, G, c;
    __host__ __device__ void init(int M, int N, int G_, int c_) { nM = M / BM; nN = N / BM; nwg = nM * nN; G = G_; c = c_; }
    __host__ __device__ bool next(int i, Unit& u) const {
        const long L = (long)i * G + c; if (L >= nwg) return false;
        int wgid = (int)L; { const int q = nwg / NXCD, r = nwg % NXCD, xcd = wgid % NXCD, off = wgid / NXCD; wgid = (xcd < r ? xcd * (q + 1) : r * (q + 1) + (xcd - r) * q) + off; }
        const int nig = WGM * nN, gid = wgid / nig, fm = gid * WGM, gsz = (nM - fm) < WGM ? (nM - fm) : WGM;
        u.pm = fm + ((wgid % nig) % gsz); u.pn = (wgid % nig) / gsz; return true;
    }
    __device__ __forceinline__ void a_ready(const Unit&) const {}
    __device__ __forceinline__ void done(const Unit&) const {}
};

struct HalfOrder {
    int c, nblk;
    __host__ __device__ void init(int G_, int c_) { nblk = G_ - G_ / 2; c = c_ - G_ / 2; }
    __host__ __device__ bool next(int i, Unit& u) const { if (c < 0) return false; const int L = i * nblk + c; if (L >= 256) return false; u.pm = L >> 2; u.pn = L & 3; return true; }
    __device__ __forceinline__ void a_ready(const Unit&) const {}
    __device__ __forceinline__ void done(const Unit&) const {}
};

__device__ __forceinline__ unsigned cvt_pk_bf16(float lo, float hi) { unsigned r; asm volatile("v_cvt_pk_bf16_f32 %0, %1, %2" : "=v"(r) : "v"(lo), "v"(hi)); return r; }

typedef float f32x16 __attribute__((ext_vector_type(16)));
constexpr float RMS_EPS = 1e-6f;
__device__ __forceinline__ float fsigmoid(float x) { return __builtin_amdgcn_rcpf(1.0f + __builtin_amdgcn_exp2f(x * -1.4426950408889634f)); }
__device__ __forceinline__ float fsilu(float x) { return x * __builtin_amdgcn_rcpf(1.0f + __builtin_amdgcn_exp2f(x * -1.4426950408889634f)); }
__device__ __forceinline__ float row_rinv16(const float* ssq, int row) {
    const f32x4* p = (const f32x4*)(ssq + (size_t)row * 16);
    const f32x4 a = p[0], b = p[1], c = p[2], d = p[3];
    const float s = ((a[0] + a[1]) + (a[2] + a[3])) + ((b[0] + b[1]) + (b[2] + b[3])) + ((c[0] + c[1]) + (c[2] + c[3])) + ((d[0] + d[1]) + (d[2] + d[3]));
    return rsqrtf(s * (1.0f / 1024.0f) + RMS_EPS);
}
__device__ __forceinline__ u32x4 pack8(const f32x4 a, const f32x4 b) {
    u32x4 w; w.x = cvt_pk_bf16(a[0], a[1]); w.y = cvt_pk_bf16(a[2], a[3]); w.z = cvt_pk_bf16(b[0], b[1]); w.w = cvt_pk_bf16(b[2], b[3]); return w;
}

template <int NB  >
__device__ __forceinline__ void rinv8(const float* ssq, int row0, float (&r)[8]) {
#pragma unroll
    for (int b = 0; b < 8 / NB; ++b) {
        f32x4 p[NB][4];
#pragma unroll
        for (int mm = 0; mm < NB; ++mm) { const int i = b * NB + mm, ai = i >> 2, m = i & 3;
#pragma unroll
            for (int q = 0; q < 4; ++q) p[mm][q] = *(const f32x4*)(ssq + (size_t)(row0 + ai * HALF + m * 16) * 16 + 4 * q); }
#pragma unroll
        for (int mm = 0; mm < NB; ++mm) {
            const f32x4 a = p[mm][0], bb = p[mm][1], c = p[mm][2], d = p[mm][3];
            const float s = ((a[0] + a[1]) + (a[2] + a[3])) + ((bb[0] + bb[1]) + (bb[2] + bb[3])) + ((c[0] + c[1]) + (c[2] + c[3])) + ((d[0] + d[1]) + (d[2] + d[3]));
            r[b * NB + mm] = rsqrtf(s * (1.0f / 1024.0f) + RMS_EPS);
        }
        asm volatile("" ::: "memory");
    }
}

struct EpiAct {
    static constexpr bool PERM = true, AFTER_DRAIN = false;
    const float* ssq; bf16_t* act;
    __device__ __forceinline__ void operator()(const f32x4 (&acc)[2][2][4][2], const Unit& u, int wr, int wc, int fr, int fq) const {
        const int colo = u.pn * 128 + wc * 32 + 8 * fq;
        f32x4 pc[4];
#pragma unroll
        for (int q = 0; q < 4; ++q) pc[q] = *(const f32x4*)(ssq + (size_t)(u.pm * BM + wr * 64 + fr) * 16 + 4 * q);
#pragma unroll
        for (int ai = 0; ai < 2; ++ai)
#pragma unroll
            for (int m = 0; m < 4; ++m) {
                const int row = u.pm * BM + ai * HALF + wr * 64 + m * 16 + fr;
                f32x4 pn[4];
                { const int g1 = (ai * 4 + m + 1) & 7, rown = u.pm * BM + (g1 >> 2) * HALF + wr * 64 + (g1 & 3) * 16 + fr;
#pragma unroll
                  for (int q = 0; q < 4; ++q) pn[q] = *(const f32x4*)(ssq + (size_t)rown * 16 + 4 * q); }
                const float r = rsqrtf((((pc[0][0] + pc[0][1]) + (pc[0][2] + pc[0][3])) + ((pc[1][0] + pc[1][1]) + (pc[1][2] + pc[1][3])) + ((pc[2][0] + pc[2][1]) + (pc[2][2] + pc[2][3])) + ((pc[3][0] + pc[3][1]) + (pc[3][2] + pc[3][3]))) * (1.0f / 1024.0f) + RMS_EPS);
#pragma unroll
                for (int q = 0; q < 4; ++q) pc[q] = pn[q];
                f32x4 o[2];
#pragma unroll
                for (int n = 0; n < 2; ++n) {
                    const f32x4 g = acc[ai][0][m][n] * r, up = acc[ai][1][m][n] * r;
#pragma unroll
                    for (int j = 0; j < 4; ++j) o[n][j] = fsilu(g[j]) * up[j];
                }
                *(u32x4*)(act + (size_t)row * 2816 + colo) = pack8(o[0], o[1]);
                asm volatile("" ::: "memory");
            }
    }
};
struct EpiRes {
    static constexpr bool PERM = true, AFTER_DRAIN = false;
    const float* hin; float* h; bf16_t* hb; float* ssq_out; float scale;
    __device__ __forceinline__ void operator()(const f32x4 (&acc)[2][2][4][2], const Unit& u, int wr, int wc, int fr, int fq) const {
#pragma unroll
        for (int ai = 0; ai < 2; ++ai) {
            f32x4 hv[4][2][2];
#pragma unroll
            for (int m = 0; m < 4; ++m)
#pragma unroll
                for (int bj = 0; bj < 2; ++bj) { const float* hp = hin + (size_t)(u.pm * BM + ai * HALF + wr * 64 + m * 16 + fr) * 1024 + u.pn * BM + bj * HALF + wc * 32 + 8 * fq;
                    hv[m][bj][0] = *(const f32x4*)hp; hv[m][bj][1] = *(const f32x4*)(hp + 4); }
#pragma unroll
            for (int m = 0; m < 4; ++m) {
                const int row = u.pm * BM + ai * HALF + wr * 64 + m * 16 + fr;
                float ss = 0.f;
#pragma unroll
                for (int bj = 0; bj < 2; ++bj) {
                    const int col0 = u.pn * BM + bj * HALF + wc * 32 + 8 * fq;
                    float* hp = h + (size_t)row * 1024 + col0;
                    const f32x4 h0 = hv[m][bj][0] + acc[ai][bj][m][0] * scale, h1 = hv[m][bj][1] + acc[ai][bj][m][1] * scale;
                    *(f32x4*)hp = h0; *(f32x4*)(hp + 4) = h1;
                    *(u32x4*)(hb + (size_t)row * 1024 + col0) = pack8(h0, h1);
                    ss += (h0[0] * h0[0] + h0[1] * h0[1]) + (h0[2] * h0[2] + h0[3] * h0[3]) + (h1[0] * h1[0] + h1[1] * h1[1]) + (h1[2] * h1[2] + h1[3] * h1[3]);
                }
                ss += __shfl_xor(ss, 16); ss += __shfl_xor(ss, 32);
                if (fq == 0) ssq_out[(size_t)row * 16 + u.pn * 4 + wc] = ss;
            }
            asm volatile("" ::: "memory");
        }
    }
};
struct EpiStash {
    static constexpr bool PERM = true, AFTER_DRAIN = false;
    float* pp;
    __device__ __forceinline__ void operator()(const f32x4 (&acc)[2][2][4][2], const Unit& u, int wr, int wc, int fr, int fq) const {
#pragma unroll
        for (int ai = 0; ai < 2; ++ai)
#pragma unroll
            for (int m = 0; m < 4; ++m) {
                const int row = u.pm * BM + ai * HALF + wr * 64 + m * 16 + fr;
#pragma unroll
                for (int bj = 0; bj < 2; ++bj) {
                    float* p = pp + (size_t)row * 1024 + u.pn * BM + bj * HALF + wc * 32 + 8 * fq;
                    *(f32x4*)p = acc[ai][bj][m][0]; *(f32x4*)(p + 4) = acc[ai][bj][m][1];
                }
                asm volatile("" ::: "memory");
            }
    }
};
struct EpiPle {
    static constexpr bool PERM = true, AFTER_DRAIN = false;
    const float* ssq_in; const float* pp; float* h; bf16_t* hb; float* ssq_out;
    __device__ __forceinline__ void operator()(const f32x4 (&acc)[2][2][4][2], const Unit& u, int wr, int wc, int fr, int fq) const {
        f32x4 pc[4];
#pragma unroll
        for (int q = 0; q < 4; ++q) pc[q] = *(const f32x4*)(ssq_in + (size_t)(u.pm * BM + wr * 64 + fr) * 16 + 4 * q);
#pragma unroll
        for (int ai = 0; ai < 2; ++ai)
#pragma unroll
            for (int m = 0; m < 4; ++m) {
                const int row = u.pm * BM + ai * HALF + wr * 64 + m * 16 + fr;
                f32x4 pn[4];
                { const int g1 = (ai * 4 + m + 1) & 7, rown = u.pm * BM + (g1 >> 2) * HALF + wr * 64 + (g1 & 3) * 16 + fr;
#pragma unroll
                  for (int q = 0; q < 4; ++q) pn[q] = *(const f32x4*)(ssq_in + (size_t)rown * 16 + 4 * q); }
                f32x4 hv[2][2], pv[2][2];
#pragma unroll
                for (int bj = 0; bj < 2; ++bj) { const size_t off = (size_t)row * 1024 + u.pn * BM + bj * HALF + wc * 32 + 8 * fq;
                    hv[bj][0] = *(const f32x4*)(h + off); hv[bj][1] = *(const f32x4*)(h + off + 4); pv[bj][0] = *(const f32x4*)(pp + off); pv[bj][1] = *(const f32x4*)(pp + off + 4); }
                const float r = rsqrtf((((pc[0][0] + pc[0][1]) + (pc[0][2] + pc[0][3])) + ((pc[1][0] + pc[1][1]) + (pc[1][2] + pc[1][3])) + ((pc[2][0] + pc[2][1]) + (pc[2][2] + pc[2][3])) + ((pc[3][0] + pc[3][1]) + (pc[3][2] + pc[3][3]))) * (1.0f / 1024.0f) + RMS_EPS);
#pragma unroll
                for (int q = 0; q < 4; ++q) pc[q] = pn[q];
                float ss = 0.f;
#pragma unroll
                for (int bj = 0; bj < 2; ++bj) {
                    const int col0 = u.pn * BM + bj * HALF + wc * 32 + 8 * fq;
                    float* hp = h + (size_t)row * 1024 + col0;
                    f32x4 h0 = hv[bj][0], h1 = hv[bj][1];
#pragma unroll
                    for (int j = 0; j < 4; ++j) { h0[j] += fsigmoid(acc[ai][bj][m][0][j] * r) * pv[bj][0][j]; h1[j] += fsigmoid(acc[ai][bj][m][1][j] * r) * pv[bj][1][j]; }
                    *(f32x4*)hp = h0; *(f32x4*)(hp + 4) = h1;
                    *(u32x4*)(hb + (size_t)row * 1024 + col0) = pack8(h0, h1);
                    ss += (h0[0] * h0[0] + h0[1] * h0[1]) + (h0[2] * h0[2] + h0[3] * h0[3]) + (h1[0] * h1[0] + h1[1] * h1[1]) + (h1[2] * h1[2] + h1[3] * h1[3]);
                }
                ss += __shfl_xor(ss, 16); ss += __shfl_xor(ss, 32);
                if (fq == 0) ssq_out[(size_t)row * 16 + u.pn * 4 + wc] = ss;
                asm volatile("" ::: "memory");
            }
    }
};
struct EpiProj {
    static constexpr bool PERM = true, AFTER_DRAIN = false;
    unsigned char* ws; float* outp; int layer;
    size_t o_ssq, o_qb, o_kb, o_vb, o_zf, o_kap, o_vap;
    __device__ __forceinline__ void operator()(const f32x4 (&acc)[2][2][4][2], const Unit& u, int wr, int wc, int fr, int fq) const {
        const int c = wc * 32 + 8 * fq;
        const float* ssq = (const float*)(ws + o_ssq); bf16_t* Qb = (bf16_t*)(ws + o_qb); bf16_t* Kb = (bf16_t*)(ws + o_kb); bf16_t* Vb = (bf16_t*)(ws + o_vb);
        float* ZF = (float*)(ws + o_zf);
        float* kout = outp + o_kap + (size_t)layer * 2048 * 512; float* vout = outp + o_vap + (size_t)layer * 2048 * 512;
        f32x4 pc[4];
#pragma unroll
        for (int q = 0; q < 4; ++q) pc[q] = *(const f32x4*)(ssq + (size_t)(u.pm * BM + wr * 64 + fr) * 16 + 4 * q);
#pragma unroll
        for (int ai = 0; ai < 2; ++ai)
#pragma unroll
            for (int m = 0; m < 4; ++m) {
                const int row = u.pm * BM + ai * HALF + wr * 64 + m * 16 + fr;
                f32x4 pn[4];
                { const int g1 = (ai * 4 + m + 1) & 7, rown = u.pm * BM + (g1 >> 2) * HALF + wr * 64 + (g1 & 3) * 16 + fr;
#pragma unroll
                  for (int q = 0; q < 4; ++q) pn[q] = *(const f32x4*)(ssq + (size_t)rown * 16 + 4 * q); }
                const float r = rsqrtf((((pc[0][0] + pc[0][1]) + (pc[0][2] + pc[0][3])) + ((pc[1][0] + pc[1][1]) + (pc[1][2] + pc[1][3])) + ((pc[2][0] + pc[2][1]) + (pc[2][2] + pc[2][3])) + ((pc[3][0] + pc[3][1]) + (pc[3][2] + pc[3][3]))) * (1.0f / 1024.0f) + RMS_EPS);
#pragma unroll
                for (int q = 0; q < 4; ++q) pc[q] = pn[q];
#pragma unroll
                for (int bj = 0; bj < 2; ++bj) {
                    const int zc = u.pn * BM + bj * HALF;
                    f32x4 v0 = acc[ai][bj][m][0] * r, v1 = acc[ai][bj][m][1] * r;
                    if (zc < 1536) {
                        const int which = zc >> 9, cc = (zc & 511) + c;
                        if (which == 0) { v0 = v0 * 0.18033688011112042f; v1 = v1 * 0.18033688011112042f; }
                        bf16_t* dst = (which == 0 ? Qb : (which == 1 ? Kb : Vb)) + (size_t)row * 512 + cc;
                        *(u32x4*)dst = pack8(v0, v1);
                        if (which > 0 && row >= 16384 - 2048) {
                            float* o = (which == 1 ? kout : vout) + (size_t)(row - (16384 - 2048)) * 512 + cc;
                            *(f32x4*)o = v0; *(f32x4*)(o + 4) = v1;
                        }
                    } else {
                        float* o = ZF + (size_t)row * 2560 + (zc - 1536) + c;
                        *(f32x4*)o = v0; *(f32x4*)(o + 4) = v1;
                    }
                }
                asm volatile("" ::: "memory");
            }
    }
};
template <class Epi, class Sched, bool ALIGN_EPI = false, bool SP2 = false>
__device__ __forceinline__ void gemm_phase(PG8_LAS unsigned char* lds, const Gemm g, const Sched& S, const Epi& E, const int wid_in) {
    int tid_o = wid_in * 64 + (int)__builtin_amdgcn_mbcnt_hi(~0u, __builtin_amdgcn_mbcnt_lo(~0u, 0u)); asm volatile("" : "+v"(tid_o));
    const int tid = tid_o, wid = __builtin_amdgcn_readfirstlane(tid >> 6), lane = tid & 63, wr = wid >> 2, wc = wid & 3, fr = lane & 15, fq = lane >> 4;
    const int K = g.K, nt = K / BK;
    unsigned voffA[2], voffB[2];
#pragma unroll
    for (int i = 0; i < 2; ++i) { int R, C; stage_rc(tid * 16 + i * 8192, R, C); const int Rb = Epi::PERM ? ((R & ~31) + perm32(R & 31)) : R;
        voffA[i] = (unsigned)(R * K + C) * 2u; voffB[i] = (unsigned)(Rb * K + C) * 2u; }
    const size_t kstep = (size_t)(BK * 2);
    const size_t hstep = (size_t)HALF * K * 2;
    const size_t tstep = 2 * hstep;
    const unsigned ldsw = (unsigned)wid * 1024u;
    const int aoff = lds_byte(wr * 64 + fr, fq * 8), boff = lds_byte(wc * 32 + fr, fq * 8);
#define PG8_SA(b, h) (((b) * 2 + (h)) * HTB)
#define PG8_SB(b, h) ((4 + (b) * 2 + (h)) * HTB)
#define PG8_STAGE(bufoff, gbase, voff) do { _Pragma("unroll") for (int _i = 0; _i < 2; ++_i) \
        __builtin_amdgcn_global_load_lds((const unsigned*)((const char*)(gbase) + (voff)[_i]), (PG8_LAS unsigned*)(lds + (bufoff) + ldsw + _i * 8192), 16, 0, 0); } while (0)
#define PG8_LDA(dst, b, h) do { _Pragma("unroll") for (int m = 0; m < 4; ++m) _Pragma("unroll") for (int k = 0; k < 2; ++k) dst[m][k] = *(const PG8_LAS bf16x8*)(lds + PG8_SA(b, h) + aoff + m * 2048 + k * 1024); } while (0)
#define PG8_LDB(dst, b, h) do { _Pragma("unroll") for (int n = 0; n < 2; ++n) _Pragma("unroll") for (int k = 0; k < 2; ++k) dst[n][k] = *(const PG8_LAS bf16x8*)(lds + PG8_SB(b, h) + boff + n * 2048 + k * 1024); } while (0)
#define PG8_MMA(ai, bj, At, Bt) do { __builtin_amdgcn_s_setprio(1); _Pragma("unroll") for (int m = 0; m < 4; ++m) _Pragma("unroll") for (int n = 0; n < 2; ++n) _Pragma("unroll") for (int k = 0; k < 2; ++k) \
        acc[ai][bj][m][n] = __builtin_amdgcn_mfma_f32_16x16x32_bf16(Bt[n][k], At[m][k], acc[ai][bj][m][n], 0, 0, 0); __builtin_amdgcn_s_setprio(0); } while (0)
#define PG8_WAIT_V(n) asm volatile("s_waitcnt vmcnt(" #n ")" ::: "memory")
#define PG8_WAIT_L(n) asm volatile("s_waitcnt lgkmcnt(" #n ")" ::: "memory")
#define PG8_BAR __builtin_amdgcn_s_barrier()
#define PG8_SCHED __builtin_amdgcn_sched_barrier(0)
    Unit cur, nxt; int ui = 0;
    if (!S.next(0, cur)) return;
    f32x4 acc[2][2][4][2];
#pragma unroll
    for (int a = 0; a < 2; ++a)
#pragma unroll
        for (int b = 0; b < 2; ++b)
#pragma unroll
            for (int m = 0; m < 4; ++m)
#pragma unroll
                for (int n = 0; n < 2; ++n) acc[a][b][m][n] = (f32x4){0.f, 0.f, 0.f, 0.f};
    bf16x8 At[4][2], B0[2][2], B1[2][2];
    const char* cA = (const char*)g.A + (size_t)cur.pm * tstep; const char* cB = (const char*)g.Bt + (size_t)cur.pn * tstep;
    S.a_ready(cur);
    if constexpr (SP2) {
        PG8_STAGE(PG8_SB(0, 0), cB, voffB); PG8_STAGE(PG8_SB(0, 1), cB + hstep, voffB); PG8_STAGE(PG8_SA(0, 0), cA, voffA); PG8_STAGE(PG8_SA(0, 1), cA + hstep, voffA);
        if (wr == 1) PG8_BAR;
        PG8_WAIT_V(2); PG8_BAR;
        PG8_STAGE(PG8_SB(1, 0), cB + kstep, voffB); PG8_STAGE(PG8_SA(1, 0), cA + kstep, voffA); PG8_STAGE(PG8_SB(1, 1), cB + hstep + kstep, voffB);
        PG8_WAIT_V(6); PG8_BAR;
    } else {
        PG8_STAGE(PG8_SB(0, 0), cB, voffB); PG8_STAGE(PG8_SA(0, 0), cA, voffA); PG8_STAGE(PG8_SB(0, 1), cB + hstep, voffB); PG8_STAGE(PG8_SA(0, 1), cA + hstep, voffA);
        if (wr == 1) PG8_BAR;
        PG8_WAIT_V(4); PG8_BAR;
        PG8_STAGE(PG8_SB(1, 0), cB + kstep, voffB); PG8_STAGE(PG8_SA(1, 0), cA + kstep, voffA); PG8_STAGE(PG8_SB(1, 1), cB + hstep + kstep, voffB);
        PG8_WAIT_V(6); PG8_BAR;
    }
    for (;;) {
        const bool has_next = S.next(ui + 1, nxt);
        const char* nA = has_next ? (const char*)g.A + (size_t)nxt.pm * tstep : cA; const char* nB = has_next ? (const char*)g.Bt + (size_t)nxt.pn * tstep : cB;
#pragma unroll 1
        for (int t = 0; t < nt; t += 2) {
            const bool last = (t == nt - 2);
            const char* a1 = cA + (size_t)(t + 1) * kstep;
            const char* a2 = last ? nA : cA + (size_t)(t + 2) * kstep; const char* b2 = last ? nB : cB + (size_t)(t + 2) * kstep;
            const char* a3 = a2 + kstep; const char* b3 = b2 + kstep;
            if (last && has_next) S.a_ready(nxt);
            if constexpr (SP2) {
            PG8_LDB(B0, 0, 0); PG8_LDB(B1, 0, 1); PG8_SCHED; PG8_LDA(At, 0, 0); PG8_STAGE(PG8_SA(1, 1), a1 + hstep, voffA);
            PG8_WAIT_V(8); PG8_WAIT_L(0); PG8_BAR; PG8_MMA(0, 0, At, B0); PG8_MMA(0, 1, At, B1); PG8_BAR; PG8_SCHED;
            PG8_LDA(At, 0, 1); PG8_STAGE(PG8_SB(0, 0), b2, voffB); PG8_STAGE(PG8_SB(0, 1), b2 + hstep, voffB); PG8_STAGE(PG8_SA(0, 0), a2, voffA);
            PG8_WAIT_V(8); PG8_WAIT_L(0); PG8_BAR; PG8_MMA(1, 0, At, B0); PG8_MMA(1, 1, At, B1); PG8_BAR; PG8_SCHED;
            PG8_LDB(B0, 1, 0); PG8_LDB(B1, 1, 1); PG8_SCHED; PG8_LDA(At, 1, 0); PG8_STAGE(PG8_SA(0, 1), a2 + hstep, voffA);
            PG8_WAIT_V(8); PG8_WAIT_L(0); PG8_BAR; PG8_MMA(0, 0, At, B0); PG8_MMA(0, 1, At, B1); PG8_BAR; PG8_SCHED;
            PG8_LDA(At, 1, 1); PG8_STAGE(PG8_SB(1, 0), b3, voffB); PG8_STAGE(PG8_SB(1, 1), b3 + hstep, voffB); PG8_STAGE(PG8_SA(1, 0), a3, voffA);
            PG8_WAIT_V(8); PG8_WAIT_L(0); PG8_BAR; PG8_MMA(1, 0, At, B0); PG8_MMA(1, 1, At, B1); PG8_BAR; PG8_SCHED;
            } else {
            PG8_LDB(B0, 0, 0); PG8_SCHED; PG8_LDA(At, 0, 0); PG8_STAGE(PG8_SA(1, 1), a1 + hstep, voffA);
            PG8_WAIT_L(8); PG8_BAR; PG8_WAIT_L(0); PG8_MMA(0, 0, At, B0); PG8_BAR; PG8_SCHED;
            PG8_LDB(B1, 0, 1); PG8_STAGE(PG8_SB(0, 0), b2, voffB);
            PG8_BAR; PG8_WAIT_L(0); PG8_MMA(0, 1, At, B1); PG8_BAR;
            PG8_LDA(At, 0, 1); PG8_STAGE(PG8_SA(0, 0), a2, voffA);
            PG8_BAR; PG8_WAIT_L(0); PG8_MMA(1, 0, At, B0); PG8_BAR; PG8_SCHED;
            PG8_STAGE(PG8_SB(0, 1), b2 + hstep, voffB);
            PG8_WAIT_V(6); PG8_BAR; PG8_MMA(1, 1, At, B1); PG8_BAR;
            PG8_LDB(B0, 1, 0); PG8_SCHED; PG8_LDA(At, 1, 0); PG8_STAGE(PG8_SA(0, 1), a2 + hstep, voffA);
            PG8_WAIT_L(8); PG8_BAR; PG8_WAIT_L(0); PG8_MMA(0, 0, At, B0); PG8_BAR; PG8_SCHED;
            PG8_LDB(B1, 1, 1); PG8_STAGE(PG8_SB(1, 0), b3, voffB);
            PG8_BAR; PG8_WAIT_L(0); PG8_MMA(0, 1, At, B1); PG8_BAR;
            PG8_LDA(At, 1, 1); PG8_STAGE(PG8_SA(1, 0), a3, voffA);
            PG8_BAR; PG8_WAIT_L(0); PG8_MMA(1, 0, At, B0); PG8_BAR; PG8_SCHED;
            PG8_STAGE(PG8_SB(1, 1), b3 + hstep, voffB);
            PG8_WAIT_V(6); PG8_BAR; PG8_MMA(1, 1, At, B1); PG8_BAR;
            }
        }
        if constexpr (ALIGN_EPI) { if (wr == 0) PG8_BAR; }
        if constexpr (!Epi::AFTER_DRAIN) { E(acc, cur, wr, wc, fr, fq); S.done(cur); }
        if (!has_next) break;
#pragma unroll
        for (int a = 0; a < 2; ++a)
#pragma unroll
            for (int b = 0; b < 2; ++b)
#pragma unroll
                for (int m = 0; m < 4; ++m)
#pragma unroll
                    for (int n = 0; n < 2; ++n) acc[a][b][m][n] = (f32x4){0.f, 0.f, 0.f, 0.f};
        cur = nxt; cA = nA; cB = nB; ++ui;
        if constexpr (ALIGN_EPI) { if (wr == 1) PG8_BAR; }
    }
    PG8_WAIT_V(0);
    if constexpr (!ALIGN_EPI) { if (wr == 0) PG8_BAR; }
    PG8_BAR;
    if constexpr (Epi::AFTER_DRAIN) { E.fused(acc, cur, wr, wc, fr, fq, lds, wid, lane); S.done(cur); }
#undef PG8_SA
#undef PG8_SB
#undef PG8_STAGE
#undef PG8_LDA
#undef PG8_LDB
#undef PG8_MMA
#undef PG8_WAIT_V
#undef PG8_WAIT_L
#undef PG8_BAR
#undef PG8_SCHED
}
}

using pg8::bf16_t; using pg8::bf16x8; using pg8::f32x4; using pg8::u32x4; using pg8::f32x16; using pg8::cvt_pk_bf16; using pg8::fsigmoid; using pg8::fsilu; using pg8::RMS_EPS;
typedef float f32x2 __attribute__((ext_vector_type(2)));
typedef unsigned u32x2 __attribute__((ext_vector_type(2)));
constexpr int T = 16384, DM = 1024, FF = 2816, PW = 3856, NPAD = 4096, NS = 32, NCH = 256  , NCHB = 128  ;
constexpr int NTHR = 512, NWAVES = 8;
constexpr int LDS_BYTES = 147456;

constexpr size_t O_YP = 0, O_YS = 16777216, O_KAP = O_YS + 32768, O_VAP = O_KAP + 2097152, O_SBP = O_VAP + 2097152, O_SCP = O_SBP + 65536,
                 O_KAS = O_SCP + 16384, O_VAS = O_KAS + 32768, O_SBS = O_VAS + 32768, O_SCS = O_SBS + 2097152, O_END = O_SCS + 524288;
constexpr size_t al256(size_t x) { return (x + 255) & ~(size_t)255; }
constexpr size_t SZ_W1GU = (size_t)5632 * 1024 * 2, SZ_W1D = (size_t)1024 * 2816 * 2, SZ_WIN = (size_t)4096 * 1024 * 2, SZ_WOUT = (size_t)1024 * 1024 * 2, SZ_WPG = SZ_WOUT, SZ_WPP = (size_t)1024 * 256 * 2;
constexpr size_t WL_W1GU = 0, WL_W1D = WL_W1GU + SZ_W1GU, WL_WIN = WL_W1D + SZ_W1D, WL_WOUT = WL_WIN + SZ_WIN, WL_W2GU = WL_WOUT + SZ_WOUT, WL_W2D = WL_W2GU + SZ_W1GU,
                 WL_WPG = WL_W2D + SZ_W1D, WL_WPP = WL_WPG + SZ_WPG, WL_SIZE = WL_WPP + SZ_WPP;
constexpr size_t WS_W = 0;
constexpr size_t WS_HB0 = al256(WS_W + 2 * WL_SIZE), WS_HB1 = WS_HB0 + (size_t)T * DM * 2;
constexpr size_t WS_ACT = WS_HB1 + (size_t)T * DM * 2;
constexpr size_t WS_QB = WS_ACT + (size_t)T * FF * 2, WS_KB = WS_QB + (size_t)T * 512 * 2, WS_VB = WS_KB + (size_t)T * 512 * 2;
constexpr size_t WS_ZF = WS_VB + (size_t)T * 512 * 2;
constexpr size_t WS_OC = WS_ZF + (size_t)T * 2560 * 4, WS_LSE = WS_OC + (size_t)3 * T * 512 * 2;
constexpr size_t WS_MIX = WS_LSE + (size_t)3 * T * 8 * 4;
constexpr size_t WS_PB = WS_MIX + (size_t)T * DM * 2;
constexpr size_t WS_UB = WS_PB + (size_t)2 * T * 256 * 2, WS_UC = WS_UB + (size_t)NCH * 32768 * 4, WS_AB = WS_UC + (size_t)NCH * 8192 * 4, WS_AC = WS_AB + (size_t)NCH * 512 * 4;
constexpr size_t WS_SSQ0 = WS_AC + (size_t)NCH * 128 * 4, WS_SSQ1 = WS_SSQ0 + (size_t)T * 16 * 4;
constexpr size_t WS_PP = WS_SSQ1 + (size_t)T * 16 * 4;
constexpr size_t WS_LB = WS_PP + (size_t)T * DM * 4;
constexpr size_t WS_HSB0 = WS_LB + 4096, WS_HSB1 = WS_HSB0 + (size_t)NS * DM * 2, WS_ACTS = WS_HSB1 + (size_t)NS * DM * 2, WS_ZS = WS_ACTS + al256((size_t)NS * FF * 2),
                 WS_MIXS = WS_ZS + (size_t)NS * NPAD * 4, WS_PSB = WS_MIXS + (size_t)NS * DM * 2, WS_SSQS0 = WS_PSB + (size_t)2 * NS * 256 * 2, WS_SSQS1 = WS_SSQS0 + (size_t)NS * 32 * 4,
                 WS_BAR = al256(WS_SSQS1 + (size_t)NS * 32 * 4), WS_BAR_BYTES = 16384, WS_FCB = WS_BAR + WS_BAR_BYTES, WS_END = WS_FCB + (size_t)T * 128 * 4;

struct Args { const float* in[28]; float* out; unsigned char* ws; };

#define LWAIT() asm volatile("s_waitcnt lgkmcnt(0)" ::: "memory")
__device__ __forceinline__ float wave_sum(float v) {
#pragma unroll
    for (int o = 1; o < 64; o <<= 1) v += __shfl_xor(v, o);
    return v;
}
__device__ __forceinline__ unsigned pk2(float lo, float hi) { return cvt_pk_bf16(lo, hi); }

__device__ __forceinline__ int map_row(int kind, int n) {
    if (kind == 1) return 256 * (n >> 7) + (n & 127);
    if (kind == 2) return 256 * (n >> 7) + (n & 127) + 128;
    if (kind == 3) return n < 3584 ? n : (n < 3600 ? 3840 + (n - 3584) : 3584 + (n - 3600));
    return n;
}
struct TrDesc { const float* W; const float* gain; bf16_t* WT; int K, N, kind, item; };
__device__ __forceinline__ void tr_load(const TrDesc& d, float (&wv)[32], int lane) {
    const int nblk = (d.N + 31) / 32, kb = d.item / nblk, nb = d.item % nblk, k0 = 64 * kb, n0 = 32 * nb;
    const int n = n0 + (lane & 31); const bool ok = n < d.N;
    const float* wp = d.W + (size_t)(k0 + (lane >> 5)) * d.N + (ok ? n : 0);
#pragma unroll
    for (int i = 0; i < 32; ++i) wv[i] = wp[(size_t)(2 * i) * d.N];
}
__device__ __forceinline__ void tr_to_lds(const TrDesc& d, const float (&wv)[32], float* scr, int lane) {
    const int nblk = (d.N + 31) / 32, nb = d.item % nblk, n0 = 32 * nb;
    const bool ok = n0 + (lane & 31) < d.N;
#pragma unroll
    for (int i = 0; i < 32; ++i) scr[(2 * i + (lane >> 5)) * 33 + (lane & 31)] = ok ? wv[i] : 0.f;
}
__device__ __forceinline__ void tr_readout(const TrDesc& d, const float* scr, int lane) {
    const int nblk = (d.N + 31) / 32, kb = d.item / nblk, nb = d.item % nblk, k0 = 64 * kb, n0 = 32 * nb;
    const int c = lane & 7;
    f32x4 g0 = (f32x4){1.f, 1.f, 1.f, 1.f}, g1 = g0;
    if (d.gain) { g0 = *(const f32x4*)(d.gain + k0 + 8 * c); g1 = *(const f32x4*)(d.gain + k0 + 8 * c + 4); }
#pragma unroll
    for (int j = 0; j < 4; ++j) {
        const int nl = (lane >> 3) + 8 * j, n = n0 + nl;
        const float* s = scr + (8 * c) * 33 + nl;
        u32x4 o; o.x = pk2(s[0 * 33] * g0[0], s[1 * 33] * g0[1]); o.y = pk2(s[2 * 33] * g0[2], s[3 * 33] * g0[3]); o.z = pk2(s[4 * 33] * g1[0], s[5 * 33] * g1[1]); o.w = pk2(s[6 * 33] * g1[2], s[7 * 33] * g1[3]);
        if (n < d.N) *(u32x4*)(d.WT + (size_t)map_row(d.kind, n) * d.K + k0 + 8 * c) = o;
    }
}

__device__ __forceinline__ void sgemm_tile(const bf16_t* A, const bf16_t* Bt, int K, int n0, float* part, int wave, int lane) {
    const int c32 = lane & 31, hi = lane >> 5, nch = K >> 6;
    f32x16 acc;
#pragma unroll
    for (int i = 0; i < 16; ++i) acc[i] = 0.f;
    for (int ch0 = wave; ch0 < nch; ch0 += 3 * NWAVES) {
        bf16x8 a[3][4], b[3][4];
#pragma unroll
        for (int c = 0; c < 3; ++c) { const int ch = ch0 + c * NWAVES;
            if (ch < nch) { const bf16_t* ap = A + (size_t)c32 * K + ch * 64 + hi * 32; const bf16_t* bp = Bt + (size_t)(n0 + c32) * K + ch * 64 + hi * 32;
#pragma unroll
                for (int j = 0; j < 4; ++j) { a[c][j] = *(const bf16x8*)(ap + 8 * j); b[c][j] = *(const bf16x8*)(bp + 8 * j); } } }
#pragma unroll
        for (int c = 0; c < 3; ++c) { const int ch = ch0 + c * NWAVES;
            if (ch < nch) {
#pragma unroll
                for (int j = 0; j < 4; ++j) acc = __builtin_amdgcn_mfma_f32_32x32x16_bf16(a[c][j], b[c][j], acc, 0, 0, 0); } }
    }
#pragma unroll
    for (int rr = 0; rr < 16; ++rr) { const int row = (rr & 3) + 8 * (rr >> 2) + 4 * hi; part[(wave * 32 + row) * 33 + c32] = acc[rr]; }
}
__device__ __forceinline__ float part_sum(const float* part, int row, int col) {
    float s = 0.f;
#pragma unroll
    for (int w = 0; w < NWAVES; ++w) s += part[(w * 32 + row) * 33 + col];
    return s;
}
__device__ __forceinline__ float row_rinv32(const float* ssqs, int row) {
    const f32x4* p = (const f32x4*)(ssqs + row * 32); float s = 0.f;
#pragma unroll
    for (int i = 0; i < 8; ++i) { const f32x4 a = p[i]; s += (a[0] + a[1]) + (a[2] + a[3]); }
    return rsqrtf(s * (1.0f / 1024.0f) + RMS_EPS);
}
constexpr int PART_FLOATS = 8 * 32 * 33;

#define ATT_LOAD_QK(UNIT) do { const int cfg_ = (UNIT) >> 12, rem_ = (UNIT) & 4095, h_ = rem_ >> 9, blk_ = rem_ & 511, dsh_ = cfg_ * 2, r_ = blk_ & ((1 << dsh_) - 1), i0_ = (blk_ >> dsh_) * 32; \
        const int tq_ = ((i0_ + c32) << dsh_) + r_; \
        _Pragma("unroll") for (int s = 0; s < 4; ++s) qf[s] = *(const bf16x8*)(Qb + (size_t)tq_ * 512 + h_ * 64 + 16 * s + 8 * hi); \
        _Pragma("unroll") for (int kt = 0; kt < 2; ++kt) { int ik = i0_ - 128 + 32 * kt + c32; ik = ik < 0 ? 0 : ik; \
            const bf16_t* kp = Kb + (size_t)((ik << dsh_) + r_) * 512 + h_ * 64 + 8 * hi; \
            _Pragma("unroll") for (int s = 0; s < 4; ++s) kf[kt][s] = *(const bf16x8*)(kp + 16 * s); } } while (0)
__device__ __forceinline__ void attn_units(unsigned char* wsb, int unit0, int nu, unsigned char* vt, int lane) {
    const bf16_t* Qb = (const bf16_t*)(wsb + WS_QB); const bf16_t* Kb = (const bf16_t*)(wsb + WS_KB); const bf16_t* Vb = (const bf16_t*)(wsb + WS_VB);
    bf16_t* Oc = (bf16_t*)(wsb + WS_OC); float* LSE = (float*)(wsb + WS_LSE);
    const int c32 = lane & 31, hi = lane >> 5;
    bf16x8 qf[4], kf[5][4];
    if (nu > 0) ATT_LOAD_QK(unit0);
    for (int ui = 0; ui < nu; ++ui) {
        const int unit = unit0 + ui;
        const int cfg = unit >> 12, rem = unit & 4095, h = rem >> 9, blk = rem & 511;
        const int dsh = cfg * 2, dil = 1 << dsh;
        const int r = blk & (dil - 1), ib = blk >> dsh, i0 = ib * 32;
        const float sl2 = exp2f(-(float)(h + 1)) * (float)dil * 1.4426950408889634f;
        const int tq = ((i0 + c32) << dsh) + r;
        float brr[16];
#pragma unroll
        for (int rr = 0; rr < 16; ++rr) brr[rr] = sl2 * (float)((rr & 3) + 8 * (rr >> 2) + 4 * hi);
#pragma unroll
        for (int kt = 2; kt < 5; ++kt) { int ik = i0 - 128 + 32 * kt + c32; ik = ik < 0 ? 0 : ik;
            const bf16_t* kp = Kb + (size_t)((ik << dsh) + r) * 512 + h * 64 + 8 * hi;
#pragma unroll
            for (int s = 0; s < 4; ++s) kf[kt][s] = *(const bf16x8*)(kp + 16 * s); }
        f32x16 st[5];
#pragma unroll
        for (int kt = 0; kt < 5; ++kt) {
            const float base = -sl2 * (float)(128 + c32 - 32 * kt);
            f32x16 a;
#pragma unroll
            for (int i = 0; i < 16; ++i) a[i] = base + brr[i];
#pragma unroll
            for (int s = 0; s < 4; ++s) a = __builtin_amdgcn_mfma_f32_32x32x16_bf16(kf[kt][s], qf[s], a, 0, 0, 0);
            st[kt] = a;
        }
        u32x4 vreg[3][4];
#pragma unroll
        for (int kt = 0; kt < 3; ++kt)
#pragma unroll
            for (int cc = 0; cc < 4; ++cc) {
                const int chunk = lane + 64 * cc, key = chunk >> 3, part = chunk & 7;
                int ik = i0 - 128 + 32 * kt + key; ik = ik < 0 ? 0 : ik;
                vreg[kt][cc] = *(const u32x4*)(Vb + (size_t)((ik << dsh) + r) * 512 + h * 64 + part * 8);
            }
#pragma unroll
        for (int rr = 0; rr < 16; ++rr) {
            const int kk = (rr & 3) + 8 * (rr >> 2) + 4 * hi;
            st[0][rr] = (kk >= c32) ? st[0][rr] : -1e30f;
            st[4][rr] = (kk <= c32) ? st[4][rr] : -1e30f;
        }
        if (i0 < 128) {
#pragma unroll
            for (int kt = 0; kt < 4; ++kt)
#pragma unroll
                for (int rr = 0; rr < 16; ++rr) { const int kk = (rr & 3) + 8 * (rr >> 2) + 4 * hi; st[kt][rr] = (i0 - 128 + 32 * kt + kk >= 0) ? st[kt][rr] : -1e30f; }
        }
        float mx = -1e30f;
#pragma unroll
        for (int kt = 0; kt < 5; ++kt)
#pragma unroll
            for (int rr = 0; rr < 16; ++rr) mx = fmaxf(mx, st[kt][rr]);
        mx = fmaxf(mx, __shfl_xor(mx, 32));
        float den = 0.f;
        bf16x8 pf[5][2];
#pragma unroll
        for (int kt = 0; kt < 5; ++kt)
#pragma unroll
            for (int s2 = 0; s2 < 2; ++s2) {
                float p[8];
#pragma unroll
                for (int j = 0; j < 8; ++j) { p[j] = __builtin_amdgcn_exp2f(st[kt][8 * s2 + j] - mx); den += p[j]; }
                u32x4 w; w.x = cvt_pk_bf16(p[0], p[1]); w.y = cvt_pk_bf16(p[2], p[3]); w.z = cvt_pk_bf16(p[4], p[5]); w.w = cvt_pk_bf16(p[6], p[7]);
                pf[kt][s2] = __builtin_bit_cast(bf16x8, w);
            }
        den += __shfl_xor(den, 32);
        if (ui + 1 < nu) ATT_LOAD_QK(unit + 1);
        f32x16 o0, o1;
#pragma unroll
        for (int i = 0; i < 16; ++i) { o0[i] = 0.f; o1[i] = 0.f; }
#pragma unroll
        for (int kt = 0; kt < 5; ++kt) {
#pragma unroll
            for (int cc = 0; cc < 4; ++cc) {
                const int chunk = lane + 64 * cc, key = chunk >> 3, part = chunk & 7;
                *(u32x4*)(vt + key * 144 + part * 16) = vreg[kt % 3][cc];
            }
            if (kt < 2) {
#pragma unroll
                for (int cc = 0; cc < 4; ++cc) {
                    const int chunk = lane + 64 * cc, key = chunk >> 3, part = chunk & 7;
                    int ik = i0 - 128 + 32 * (kt + 3) + key; ik = ik < 0 ? 0 : ik;
                    vreg[kt][cc] = *(const u32x4*)(Vb + (size_t)((ik << dsh) + r) * 512 + h * 64 + part * 8);
                }
            }
            LWAIT();
#pragma unroll
            for (int s2 = 0; s2 < 2; ++s2) {
#pragma unroll
                for (int dh = 0; dh < 2; ++dh) {
                    typedef short v4i16_t __attribute__((ext_vector_type(4)));
                    const int trow = (lane >> 2) & 3, tcol = 16 * ((lane >> 4) & 1) + 4 * (lane & 3) + 32 * dh;
                    const v4i16_t lo4 = __builtin_amdgcn_ds_read_tr16_b64_v4i16((__attribute__((address_space(3))) v4i16_t*)(vt + (16 * s2 + 4 * hi + trow) * 144 + tcol * 2));
                    const v4i16_t hi4 = __builtin_amdgcn_ds_read_tr16_b64_v4i16((__attribute__((address_space(3))) v4i16_t*)(vt + (16 * s2 + 8 + 4 * hi + trow) * 144 + tcol * 2));
                    bf16x8 vf; vf[0] = lo4[0]; vf[1] = lo4[1]; vf[2] = lo4[2]; vf[3] = lo4[3]; vf[4] = hi4[0]; vf[5] = hi4[1]; vf[6] = hi4[2]; vf[7] = hi4[3];
                    if (dh == 0) o0 = __builtin_amdgcn_mfma_f32_32x32x16_bf16(vf, pf[kt][s2], o0, 0, 0, 0);
                    else         o1 = __builtin_amdgcn_mfma_f32_32x32x16_bf16(vf, pf[kt][s2], o1, 0, 0, 0);
                }
            }
            LWAIT();
        }
        const float inv = 1.0f / den;
        bf16_t* op = Oc + ((size_t)cfg * T + tq) * 512 + h * 64 + 4 * hi;
#pragma unroll
        for (int g = 0; g < 4; ++g) {
            u32x2 w0, w1;
            w0.x = cvt_pk_bf16(o0[4 * g] * inv, o0[4 * g + 1] * inv); w0.y = cvt_pk_bf16(o0[4 * g + 2] * inv, o0[4 * g + 3] * inv);
            w1.x = cvt_pk_bf16(o1[4 * g] * inv, o1[4 * g + 1] * inv); w1.y = cvt_pk_bf16(o1[4 * g + 2] * inv, o1[4 * g + 3] * inv);
            *(u32x2*)(op + 8 * g) = w0; *(u32x2*)(op + 32 + 8 * g) = w1;
        }
        if (hi == 0) LSE[((size_t)cfg * T + tq) * 8 + h] = (mx + __builtin_amdgcn_logf(den)) * 0.6931471805599453f;
    }
}

#define LO2(v) (__builtin_shufflevector((v), (v), 0, 1))
#define HI2(v) (__builtin_shufflevector((v), (v), 2, 3))
__device__ __forceinline__ f32x4 fgate4(f32x4 z, f32x4 lbv) { f32x4 o;
#pragma unroll
    for (int j = 0; j < 4; ++j) o[j] = lbv[j] + (1.0f - lbv[j]) * fsigmoid(z[j]);
    return o; }
__device__ __forceinline__ f32x4 silu4(f32x4 z) { f32x4 o;
#pragma unroll
    for (int j = 0; j < 4; ++j) o[j] = fsilu(z[j]);
    return o; }
__device__ __forceinline__ void b_local(const float* ZF, const float* lb, float* UB, float* AB, int n, int h, unsigned char* smem, int tid, int wave, int lane) {
    float* fL = (float*)smem; float* vL = fL + 128 * 128;
    const int t0 = 128 * n;
    {
        f32x4 rf[8], rv[4];
        const f32x4 lbv = *(const f32x4*)(lb + h * 128 + 4 * (tid & 31));
#pragma unroll
        for (int i = 0; i < 8; ++i) { const int idx = tid + NTHR * i, t = idx >> 5, k4 = idx & 31; rf[i] = *(const f32x4*)(ZF + (size_t)(t0 + t) * 2560 + 512 + h * 128 + 4 * k4); }
#pragma unroll
        for (int i = 0; i < 4; ++i) { const int idx = tid + NTHR * i, t = idx >> 4, v4 = idx & 15; rv[i] = *(const f32x4*)(ZF + (size_t)(t0 + t) * 2560 + 1024 + h * 64 + 4 * v4); }
#pragma unroll
        for (int i = 0; i < 8; ++i) { const int idx = tid + NTHR * i, t = idx >> 5, k4 = idx & 31; *(f32x4*)(fL + t * 128 + 4 * k4) = fgate4(rf[i], lbv); }
#pragma unroll
        for (int i = 0; i < 4; ++i) { const int idx = tid + NTHR * i, t = idx >> 4, v4 = idx & 15; *(f32x4*)(vL + t * 64 + 4 * v4) = rv[i]; }
    }
    __syncthreads();
    f32x2 S[8];
#pragma unroll
    for (int k = 0; k < 8; ++k) S[k] = (f32x2){0.f, 0.f};
    {
        f32x4 fc[4]; float vc = vL[lane];
#pragma unroll
        for (int q4 = 0; q4 < 4; ++q4) fc[q4] = *(const f32x4*)(fL + 16 * wave + 4 * q4);
#pragma unroll 2
        for (int t = 0; t < 128; ++t) {
            const int tn = (t + 1) & 127;
            f32x4 fn[4]; const float vn = vL[tn * 64 + lane];
#pragma unroll
            for (int q4 = 0; q4 < 4; ++q4) fn[q4] = *(const f32x4*)(fL + tn * 128 + 16 * wave + 4 * q4);
            const f32x2 vc2 = (f32x2){vc, vc};
#pragma unroll
            for (int q4 = 0; q4 < 4; ++q4) { S[2 * q4] = LO2(fc[q4]) * (S[2 * q4] - vc2) + vc2; S[2 * q4 + 1] = HI2(fc[q4]) * (S[2 * q4 + 1] - vc2) + vc2; }
#pragma unroll
            for (int q4 = 0; q4 < 4; ++q4) fc[q4] = fn[q4];
            vc = vn;
        }
    }
    float* up = UB + ((size_t)(n * 4 + h) * 128 + 16 * wave) * 64 + lane;
#pragma unroll
    for (int k = 0; k < 8; ++k) { up[(2 * k) * 64] = S[k][0]; up[(2 * k + 1) * 64] = S[k][1]; }
    { float ap = 1.f; const int kq = lane & 15, pt = lane >> 4;
#pragma unroll
      for (int t = 0; t < 32; ++t) ap *= fL[(32 * pt + t) * 128 + 16 * wave + kq];
      ap *= __shfl_xor(ap, 16); ap *= __shfl_xor(ap, 32);
      if (lane < 16) AB[(size_t)(n * 4 + h) * 128 + 16 * wave + lane] = ap; }
    __syncthreads();
}
__device__ __forceinline__ void b_output(const float* ZF, const float* lb, const float* S0B, const float* bnorm, bf16_t* mixed, int n, int h, unsigned char* smem, int tid, int wave, int lane) {
    float* fL = (float*)smem; float* qL = fL + 32 * 128; float* vL = qL + 32 * 128; float* oP = vL + 32 * 64;
    f32x2 S[8];
    { const float* sp = S0B + ((size_t)(n * 4 + h) * 128 + 16 * wave) * 64 + lane;
#pragma unroll
      for (int k = 0; k < 8; ++k) { S[k][0] = sp[(2 * k) * 64]; S[k][1] = sp[(2 * k + 1) * 64]; } }
    const int lt = tid >> 5, lk4 = tid & 31;
    const int rt = tid >> 4, rv4 = tid & 15;
    const f32x4 lbv = *(const f32x4*)(lb + h * 128 + 4 * lk4);
    const f32x4 bn = *(const f32x4*)(bnorm + h * 64 + 4 * rv4);
    f32x4 rf[2], rq[2], rv;
    { const int t0 = 128 * n;
#pragma unroll
      for (int i = 0; i < 2; ++i) { const float* zr = ZF + (size_t)(t0 + lt + 16 * i) * 2560 + h * 128 + 4 * lk4; rf[i] = *(const f32x4*)(zr + 512); rq[i] = *(const f32x4*)zr; }
      rv = *(const f32x4*)(ZF + (size_t)(t0 + rt) * 2560 + 1024 + h * 64 + 4 * rv4); }
    for (int sc = 0; sc < 4; ++sc) {
        const int t0 = 128 * n + 32 * sc;
#pragma unroll
        for (int i = 0; i < 2; ++i) { *(f32x4*)(fL + (lt + 16 * i) * 128 + 4 * lk4) = fgate4(rf[i], lbv); *(f32x4*)(qL + (lt + 16 * i) * 128 + 4 * lk4) = silu4(rq[i]); }
        *(f32x4*)(vL + rt * 64 + 4 * rv4) = rv;
        const f32x4 g = *(const f32x4*)(ZF + (size_t)(t0 + rt) * 2560 + 1280 + h * 64 + 4 * rv4);
        __syncthreads();
        if (sc < 3) {
#pragma unroll
            for (int i = 0; i < 2; ++i) { const float* zr = ZF + (size_t)(t0 + 32 + lt + 16 * i) * 2560 + h * 128 + 4 * lk4; rf[i] = *(const f32x4*)(zr + 512); rq[i] = *(const f32x4*)zr; }
            rv = *(const f32x4*)(ZF + (size_t)(t0 + 32 + rt) * 2560 + 1024 + h * 64 + 4 * rv4);
        }
        {
            f32x4 fc[4], qc[4]; float vc = vL[lane];
#pragma unroll
            for (int q4 = 0; q4 < 4; ++q4) { fc[q4] = *(const f32x4*)(fL + 16 * wave + 4 * q4); qc[q4] = *(const f32x4*)(qL + 16 * wave + 4 * q4); }
#pragma unroll 2
            for (int t = 0; t < 32; ++t) {
                const int tn = (t + 1) & 31;
                f32x4 fn[4], qn[4]; const float vn = vL[tn * 64 + lane];
#pragma unroll
                for (int q4 = 0; q4 < 4; ++q4) { fn[q4] = *(const f32x4*)(fL + tn * 128 + 16 * wave + 4 * q4); qn[q4] = *(const f32x4*)(qL + tn * 128 + 16 * wave + 4 * q4); }
                const f32x2 vc2 = (f32x2){vc, vc}; f32x2 oa = (f32x2){0.f, 0.f}, ob = oa;
#pragma unroll
                for (int q4 = 0; q4 < 4; ++q4) {
                    const f32x2 s0 = LO2(fc[q4]) * (S[2 * q4] - vc2) + vc2, s1 = HI2(fc[q4]) * (S[2 * q4 + 1] - vc2) + vc2;
                    S[2 * q4] = s0; S[2 * q4 + 1] = s1; oa += LO2(qc[q4]) * s0; ob += HI2(qc[q4]) * s1;
                }
                oa += ob;
                oP[(wave * 32 + t) * 64 + lane] = oa[0] + oa[1];
#pragma unroll
                for (int q4 = 0; q4 < 4; ++q4) { fc[q4] = fn[q4]; qc[q4] = qn[q4]; }
                vc = vn;
            }
        }
        __syncthreads();
        { f32x4 o = (f32x4){0.f, 0.f, 0.f, 0.f};
#pragma unroll
          for (int w = 0; w < 8; ++w) o += *(const f32x4*)(oP + (w * 32 + rt) * 64 + 4 * rv4);
          float ss = (o[0] * o[0] + o[1] * o[1]) + (o[2] * o[2] + o[3] * o[3]);
#pragma unroll
          for (int d = 1; d < 16; d <<= 1) ss += __shfl_xor(ss, d);
          const float rinv = rsqrtf(ss * (1.0f / 64.0f) + RMS_EPS);
          u32x2 w2; w2.x = cvt_pk_bf16(o[0] * rinv * bn[0] * fsigmoid(g[0]), o[1] * rinv * bn[1] * fsigmoid(g[1])); w2.y = cvt_pk_bf16(o[2] * rinv * bn[2] * fsigmoid(g[2]), o[3] * rinv * bn[3] * fsigmoid(g[3]));
          *(u32x2*)(mixed + (size_t)(t0 + rt) * 1024 + 512 + h * 64 + 4 * rv4) = w2; }
    }
    __syncthreads();
}

__device__ __forceinline__ float logsig16_exp(float x) {
    const float ls = fminf(x, 0.f) - __logf(1.0f + __expf(-fabsf(x)));
    return __expf(ls * 0.0625f);
}
template <bool OUT>
__device__ __forceinline__ void c_task(const float* ZF, float* FCB, const float* cwg, const float* cbias, float* UC, float* AC, const float* cnorm, bf16_t* mixed,
                                       int n, int h, float* wl  , int lane) {
    float* fcL = wl; float* kcL = wl + 512; float* qcL = wl + 1024; float* vL = wl + 1536; float* gL = wl + 2560;
    const int k = lane & 31, th = lane >> 5;
    float cw[16];
#pragma unroll
    for (int r = 0; r < 16; ++r) cw[r] = OUT ? 0.f : cwg[r * 128 + h * 32 + k];
    const float cb = OUT ? 0.f : cbias[h * 32 + k];
    const float cn = OUT ? cnorm[h * 64 + lane] : 0.f;
    f32x2 S[16];
    float* ucp = UC + ((size_t)(n * 4 + h) * 32) * 64 + lane;
#pragma unroll
    for (int kk = 0; kk < 16; ++kk) { S[kk][0] = OUT ? ucp[(2 * kk) * 64] : 0.f; S[kk][1] = OUT ? ucp[(2 * kk + 1) * 64] : 0.f; }
    float ap = 1.f;
#pragma unroll 1
    for (int sc = 0; sc < 4; ++sc) {
        const int t0 = 64 * n + 16 * sc;
        {
            float rk[8], rq[8], rfc[8], rvv[16], rgg[16]; f32x4 rclr = (f32x4){0.f, 0.f, 0.f, 0.f};
#pragma unroll
            for (int i = 0; i < 8; ++i) { const int t = 2 * i + th; const float* zr = ZF + (size_t)(t0 + t) * 2560;
                rk[i] = zr[1664 + h * 32 + k]; rq[i] = OUT ? zr[1536 + h * 32 + k] : 0.f; rfc[i] = OUT ? FCB[(size_t)(t0 + t) * 128 + h * 32 + k] : 0.f; }
#pragma unroll
            for (int t = 0; t < 16; ++t) { rvv[t] = ZF[(size_t)(t0 + t) * 2560 + 1792 + h * 64 + lane]; rgg[t] = OUT ? ZF[(size_t)(t0 + t) * 2560 + 2048 + h * 64 + lane] : 0.f; }
            if (!OUT) rclr = *(const f32x4*)(ZF + (size_t)(t0 + (lane >> 2)) * 2560 + 2304 + 4 * (lane & 3));
#pragma unroll
            for (int i = 0; i < 8; ++i) { const int t = 2 * i + th; kcL[t * 32 + k] = rk[i]; if (OUT) { qcL[t * 32 + k] = rq[i] * 0.17677669529663687f; fcL[t * 32 + k] = rfc[i]; } }
#pragma unroll
            for (int t = 0; t < 16; ++t) { vL[t * 64 + lane] = rvv[t]; if (OUT) gL[t * 64 + lane] = fsilu(rgg[t]); }
            if (!OUT) {
                *(f32x4*)(gL + 4 * lane) = rclr;
                LWAIT();
#pragma unroll 2
                for (int i = 0; i < 8; ++i) { const int t = 2 * i + th;
                    float x = cb;
#pragma unroll
                    for (int r4 = 0; r4 < 4; ++r4) { const f32x4 c4 = *(const f32x4*)(gL + t * 16 + 4 * r4); x += c4[0] * cw[4 * r4] + c4[1] * cw[4 * r4 + 1] + c4[2] * cw[4 * r4 + 2] + c4[3] * cw[4 * r4 + 3]; }
                    const float fv = logsig16_exp(x);
                    fcL[t * 32 + k] = fv; FCB[(size_t)(t0 + t) * 128 + h * 32 + k] = fv; }
            }
        }
        LWAIT();
        if (!OUT) {
#pragma unroll 4
            for (int t = 0; t < 16; ++t) ap *= fcL[t * 32 + k];
        }
        {
            f32x4 fcu[4], kcu[4], qcu[4];
#pragma unroll
            for (int j = 0; j < 4; ++j) { fcu[j] = *(const f32x4*)(fcL + 4 * j); kcu[j] = *(const f32x4*)(kcL + 4 * j); qcu[j] = OUT ? *(const f32x4*)(qcL + 4 * j) : (f32x4){0.f, 0.f, 0.f, 0.f}; }
            float vv = vL[lane]; f32x2 o2 = (f32x2){0.f, 0.f};
#pragma unroll 2
            for (int u = 0; u < 32; ++u) {
                const int half = u & 1, t = u >> 1, un = (u + 1) & 31, tn = un >> 1, hn = un & 1;
                f32x4 fnu[4], knu[4], qnu[4];
#pragma unroll
                for (int j = 0; j < 4; ++j) { fnu[j] = *(const f32x4*)(fcL + tn * 32 + 16 * hn + 4 * j); knu[j] = *(const f32x4*)(kcL + tn * 32 + 16 * hn + 4 * j); qnu[j] = OUT ? *(const f32x4*)(qcL + tn * 32 + 16 * hn + 4 * j) : (f32x4){0.f, 0.f, 0.f, 0.f}; }
                const float vnx = vL[tn * 64 + lane];
                const f32x2 vv2 = (f32x2){vv, vv};
#pragma unroll
                for (int j = 0; j < 4; ++j) {
                    if (half == 0) { const f32x2 s0 = LO2(fcu[j]) * S[2 * j] + LO2(kcu[j]) * vv2, s1 = HI2(fcu[j]) * S[2 * j + 1] + HI2(kcu[j]) * vv2; S[2 * j] = s0; S[2 * j + 1] = s1; if (OUT) { o2 += LO2(qcu[j]) * s0; o2 += HI2(qcu[j]) * s1; } }
                    else           { const f32x2 s0 = LO2(fcu[j]) * S[8 + 2 * j] + LO2(kcu[j]) * vv2, s1 = HI2(fcu[j]) * S[8 + 2 * j + 1] + HI2(kcu[j]) * vv2; S[8 + 2 * j] = s0; S[8 + 2 * j + 1] = s1; if (OUT) { o2 += LO2(qcu[j]) * s0; o2 += HI2(qcu[j]) * s1; } }
                }
                if (half == 1) { if (OUT) vL[t * 64 + lane] = o2[0] + o2[1]; o2 = (f32x2){0.f, 0.f}; vv = vnx; }
#pragma unroll
                for (int j = 0; j < 4; ++j) { fcu[j] = fnu[j]; kcu[j] = knu[j]; qcu[j] = qnu[j]; }
            }
        }
        LWAIT();
        if (OUT) {
            { const int t = lane >> 2, part = lane & 3; float ss = 0.f;
#pragma unroll
              for (int i = 0; i < 4; ++i) { const f32x4 x = *(const f32x4*)(vL + t * 64 + part * 16 + 4 * i); ss += (x[0] * x[0] + x[1] * x[1]) + (x[2] * x[2] + x[3] * x[3]); }
              ss += __shfl_xor(ss, 1); ss += __shfl_xor(ss, 2);
              if (part == 0) fcL[t] = rsqrtf(ss * (1.0f / 64.0f) + RMS_EPS); }
            LWAIT();
#pragma unroll 4
            for (int t = 0; t < 16; ++t) {
                const float y = vL[t * 64 + lane] * fcL[t] * cn * gL[t * 64 + lane];
                mixed[(size_t)(t0 + t) * 1024 + 768 + h * 64 + lane] = (bf16_t)(cvt_pk_bf16(y, 0.f) & 0xffffu);
            }
            LWAIT();
        }
    }
    if (!OUT) {
#pragma unroll
        for (int kk = 0; kk < 16; ++kk) { ucp[(2 * kk) * 64] = S[kk][0]; ucp[(2 * kk + 1) * 64] = S[kk][1]; }
        if (lane < 32) AC[(size_t)(n * 4 + h) * 32 + k] = ap;
    }
}

__device__ __forceinline__ void s_attn(const float* zs, const float* ck, const float* cv  , bf16_t* mixs, float* kas, float* vas,
                                       int b, int h, unsigned char* smem, int tid, int wave, int lane) {
    float* sc = (float*)smem;
    float* pr = sc + 400;
    float* po = pr + 400;
    const float* zr = zs + (size_t)b * NPAD;
    const float slope = exp2f(-(float)(h + 1));
    if (tid < 387) {
        const int cfg = tid / 129, j = tid % 129, dil = 1 << (2 * cfg);
        const float* kr = (j == 0) ? (zr + 512 + h * 64) : (ck + ((size_t)b * 2048 + (2048 - j * dil)) * 512 + h * 64);
        float d = 0.f;
#pragma unroll
        for (int i = 0; i < 16; ++i) { const f32x4 kv = *(const f32x4*)(kr + 4 * i), qv = *(const f32x4*)(zr + h * 64 + 4 * i); d += kv[0] * qv[0] + kv[1] * qv[1] + kv[2] * qv[2] + kv[3] * qv[3]; }
        sc[tid] = d * 0.125f - slope * (float)(j * dil);
        ((int*)(po + 512))[tid] = (j == 0) ? -1 : (2048 - j * dil);
    }
    __syncthreads();
    float mx = -1e30f;
    for (int i = lane; i < 387; i += 64) mx = fmaxf(mx, sc[i]);
#pragma unroll
    for (int o = 1; o < 64; o <<= 1) mx = fmaxf(mx, __shfl_xor(mx, o));
    float den = 0.f;
    for (int i = lane; i < 387; i += 64) den += __expf(sc[i] - mx);
    den = wave_sum(den);
    if (tid < 387) pr[tid] = __expf(sc[tid] - mx) / den;
    __syncthreads();
    {
        const int d4 = tid & 15, part = tid >> 4;
        const int* ro = (const int*)(po + 512);
        const float* vnew = zr + 1024 + h * 64; const float* vbase = cv + (size_t)b * 2048 * 512 + h * 64;
        f32x4 vrow[13]; float pw[13];
#pragma unroll
        for (int j = 0; j < 13; ++j) { const int i = part + 32 * j; const bool ok = i < 387; const int rr = ok ? ro[i] : -1;
            const float* vr = (rr < 0) ? vnew : (vbase + (size_t)rr * 512);
            vrow[j] = *(const f32x4*)(vr + 4 * d4); pw[j] = ok ? pr[i] : 0.f; }
        f32x4 a = (f32x4){0.f, 0.f, 0.f, 0.f};
#pragma unroll
        for (int j = 0; j < 13; ++j) a += vrow[j] * pw[j];
        float* pp2 = po + 1024;
        *(f32x4*)(pp2 + part * 64 + 4 * d4) = a;
    }
    __syncthreads();
    if (tid < 64) { float o = 0.f;
#pragma unroll
        for (int p = 0; p < 32; ++p) o += po[1024 + p * 64 + tid];
        po[tid] = o; }
    __syncthreads();
    if (tid < 64) {
        const float o = po[tid];
        mixs[(size_t)b * 1024 + h * 64 + tid] = (bf16_t)(cvt_pk_bf16(o, 0.f) & 0xffffu);
        kas[(size_t)b * 512 + h * 64 + tid] = zr[512 + h * 64 + tid];
        vas[(size_t)b * 512 + h * 64 + tid] = zr[1024 + h * 64 + tid];
    }
    __syncthreads();
}
__device__ __forceinline__ void s_b(const float* zs, const float* sb0  , float* sbo  , const float* lb, const float* bnorm, bf16_t* mixs,
                                    int b, int h, unsigned char* smem, int tid, int wave, int lane) {
    float* po = (float*)smem;
    const float* zr = zs + (size_t)b * NPAD;
    const float vv = zr[2560 + h * 64 + lane];
    float op = 0.f;
    {
        float s0v[16], zf[16], zq[16], lbk[16];
#pragma unroll
        for (int kk = 0; kk < 16; ++kk) { const int k = 16 * wave + kk; s0v[kk] = sb0[(((size_t)b * 4 + h) * 128 + k) * 64 + lane]; zf[kk] = zr[2048 + h * 128 + k]; zq[kk] = zr[1536 + h * 128 + k]; lbk[kk] = lb[h * 128 + k]; }
#pragma unroll
        for (int kk = 0; kk < 16; ++kk) { const int k = 16 * wave + kk;
            const float f = lbk[kk] + (1.0f - lbk[kk]) * (1.0f / (1.0f + __expf(-zf[kk])));
            const float s1 = f * s0v[kk] + (1.0f - f) * vv;
            sbo[(((size_t)b * 4 + h) * 128 + k) * 64 + lane] = s1;
            op += fsilu(zq[kk]) * s1; }
    }
    po[wave * 64 + lane] = op;
    __syncthreads();
    if (tid < 64) {
        float o = 0.f;
#pragma unroll
        for (int w = 0; w < 8; ++w) o += po[w * 64 + tid];
        const float ss = wave_sum(o * o);
        const float y = o * rsqrtf(ss * (1.0f / 64.0f) + RMS_EPS) * bnorm[h * 64 + tid] * fsigmoid(zr[2816 + h * 64 + tid]);
        mixs[(size_t)b * 1024 + 512 + h * 64 + tid] = (bf16_t)(cvt_pk_bf16(y, 0.f) & 0xffffu);
    }
    __syncthreads();
}
__device__ __forceinline__ void s_c(const float* zs, const float* sc0  , float* sco, const float* cwg, const float* cbias, const float* cnorm, bf16_t* mixs,
                                    int b, int h, unsigned char* smem, int tid, int wave, int lane) {
    float* po = (float*)smem;
    const float* zr = zs + (size_t)b * NPAD;
    const float vv = zr[3328 + h * 64 + lane];
    float op = 0.f;
#pragma unroll
    for (int kk = 0; kk < 4; ++kk) {
        const int k = 4 * wave + kk;
        float x = cbias[h * 32 + k];
#pragma unroll
        for (int r = 0; r < 16; ++r) x += zr[3840 + r] * cwg[r * 128 + h * 32 + k];
        const float f = logsig16_exp(x);
        const size_t si = (((size_t)b * 4 + h) * 32 + k) * 64 + lane;
        const float s1 = f * sc0[si] + zr[3200 + h * 32 + k] * vv;
        sco[si] = s1;
        op += zr[3072 + h * 32 + k] * 0.17677669529663687f * s1;
    }
    po[wave * 64 + lane] = op;
    __syncthreads();
    if (tid < 64) {
        float o = 0.f;
#pragma unroll
        for (int w = 0; w < 8; ++w) o += po[w * 64 + tid];
        const float ss = wave_sum(o * o);
        const float y = o * rsqrtf(ss * (1.0f / 64.0f) + RMS_EPS) * cnorm[h * 64 + tid] * fsilu(zr[3584 + h * 64 + tid]);
        mixs[(size_t)b * 1024 + 768 + h * 64 + tid] = (bf16_t)(cvt_pk_bf16(y, 0.f) & 0xffffu);
    }
    __syncthreads();
}

#define LAS __attribute__((address_space(3)))
#define XB_TMO      128
#define XB_XCNT(j)  (256  + 64 * (j))
#define XB_XSUB(j)  (1280 + 64 * (j))
#define XB_XGEN(j)  (2304 + 64 * (j))
#define XB_TOP      3328
#define XB_TOPGEN   3392
#define XCD_BAR_WORDS 3456
#define XB_SPIN_CAP (1u << 18)

__device__ __forceinline__ unsigned xb_ld(unsigned* p)              { return __hip_atomic_load(p, __ATOMIC_RELAXED, __HIP_MEMORY_SCOPE_AGENT); }
__device__ __forceinline__ unsigned xb_add(unsigned* p, unsigned v) { return __hip_atomic_fetch_add(p, v, __ATOMIC_RELAXED, __HIP_MEMORY_SCOPE_AGENT); }
__device__ __forceinline__ unsigned xb_xcc_id() { return (unsigned)__builtin_amdgcn_s_getreg((3 << 11) | 20) & 0xFu; }
#define XB_SPIN(cond, bar) do { unsigned _sp = 0; while (cond) { __builtin_amdgcn_s_sleep(1); \
    if ((++_sp & 255u) == 0u) { if (xb_ld(&(bar)[XB_TMO])) break; if (_sp > XB_SPIN_CAP) { atomicAdd(&(bar)[XB_TMO], 1u); break; } } } } while (0)

struct XcdBarrier {
    unsigned* bar; unsigned x;
    volatile LAS unsigned* st;
};

__device__ __forceinline__ XcdBarrier xcd_barrier_post(unsigned* bar, volatile LAS unsigned* st, bool is_t0) {
    XcdBarrier b; b.bar = bar; b.x = xb_xcc_id(); b.st = st;
    if (is_t0) (void)xb_add(&bar[XB_XCNT(b.x)], 1u);
    return b;
}
__device__ __forceinline__ void xcd_barrier_complete(unsigned* bar, unsigned x, unsigned& nloc, unsigned& nx) {
    const unsigned G = gridDim.x * gridDim.y * gridDim.z;
    unsigned sum, cnt, mine, sp = 0u;
    for (;;) {
        sum = 0u; cnt = 0u; mine = 0u;
#pragma unroll
        for (unsigned j = 0; j < 16; ++j) { const unsigned c = xb_ld(&bar[XB_XCNT(j)]); sum += c; cnt += (c > 0u) ? 1u : 0u; mine = (j == x) ? c : mine; }
        if (sum == G) break;
        __builtin_amdgcn_s_sleep(1);
        if ((++sp & 255u) == 0u) { if (xb_ld(&bar[XB_TMO])) break; if (sp > XB_SPIN_CAP) { atomicAdd(&bar[XB_TMO], 1u); break; } }
    }
    nloc = mine > 0u ? mine : 1u; nx = cnt > 0u ? cnt : 1u;
}

__device__ __forceinline__ void xcd_barrier(const XcdBarrier& b, bool is_t0) {
    asm volatile("s_waitcnt vmcnt(0)" ::: "memory");
    __syncthreads();
    if (is_t0) {
        unsigned* bar = b.bar;
        __builtin_amdgcn_s_waitcnt(0);
        unsigned nloc = b.st[0], nx = b.st[1];
        if (nloc == 0u) { xcd_barrier_complete(bar, b.x, nloc, nx); b.st[0] = nloc; b.st[1] = nx; }
        const unsigned old = xb_add(&bar[XB_XSUB(b.x)], 1u);
        const unsigned gen = old / nloc;
        if (old + 1u == (gen + 1u) * nloc) {
            __builtin_amdgcn_fence(__ATOMIC_RELEASE, "agent");
            asm volatile("s_waitcnt vmcnt(0)" ::: "memory");
            const unsigned og = xb_add(&bar[XB_TOP], 1u);
            const unsigned tg = og / nx;
            if (og + 1u == (tg + 1u) * nx) xb_add(&bar[XB_TOPGEN], 1u);
            else XB_SPIN(xb_ld(&bar[XB_TOPGEN]) == tg, bar);
            __builtin_amdgcn_fence(__ATOMIC_ACQUIRE, "agent");
            xb_add(&bar[XB_XGEN(b.x)], 1u);
            asm volatile("s_waitcnt vmcnt(0)" ::: "memory");
        } else {
            XB_SPIN(xb_ld(&bar[XB_XGEN(b.x)]) == gen, bar);
            __builtin_amdgcn_fence(__ATOMIC_ACQUIRE, "agent");
            asm volatile("s_waitcnt vmcnt(0)" ::: "memory");
        }
    }
    __syncthreads();
}

#ifndef REP_ATT
#define REP_ATT 1
#endif
#ifndef REP_BL
#define REP_BL 1
#endif
#ifndef REP_SMP
#define REP_SMP 1
#endif
#ifndef REP_BO
#define REP_BO 1
#endif
#ifndef REP_CO
#define REP_CO 1
#endif
#ifndef REP_MRG
#define REP_MRG 1
#endif
#ifndef REP_P4
#define REP_P4 1
#endif
#ifndef REP_P6
#define REP_P6 1
#endif
#ifndef REP_G1
#define REP_G1 1
#endif
#ifndef REP_P0
#define REP_P0 1
#endif
#ifndef REP_G3
#define REP_G3 1
#endif
#ifndef REP_SCANPROBE
#define REP_SCANPROBE 1
#endif
#ifndef EN_ATT
#define EN_ATT 1
#endif
#ifndef EN_BL
#define EN_BL 1
#endif
#ifndef EN_CL
#define EN_CL 1
#endif
#ifndef EN_BO
#define EN_BO 1
#endif
#ifndef EN_CO
#define EN_CO 1
#endif
#ifndef EN_EPIPROJ
#define EN_EPIPROJ 1
#endif
#ifndef EN_EPIACT
#define EN_EPIACT 1
#endif
#ifndef EN_EPISTASH
#define EN_EPISTASH 1
#endif
#ifndef EN_EPIPLE
#define EN_EPIPLE 1
#endif
#ifndef EN_EPIRES
#define EN_EPIRES 1
#endif


__device__ __forceinline__ int owave(int w) { asm volatile("" : "+s"(w)); return __builtin_amdgcn_readfirstlane(w); }
__device__ __forceinline__ int olane() { int t = (int)__builtin_amdgcn_mbcnt_hi(~0u, __builtin_amdgcn_mbcnt_lo(~0u, 0u)); asm volatile("" : "+v"(t)); return t; }
typedef const Args __attribute__((address_space(4)))* KArgP;
__device__ __forceinline__ KArgP kargs_ptr() { KArgP p = (KArgP)__builtin_amdgcn_kernarg_segment_ptr(); asm volatile("" : "+s"(p)); return p; }
__global__ void __launch_bounds__(NTHR, 2) mega_fwd(Args args) {
    extern __shared__ __attribute__((aligned(16))) unsigned char smem[];
    cg::grid_group grid = cg::this_grid();
    const int wv0 = __builtin_amdgcn_readfirstlane((int)threadIdx.x >> 6);
    __builtin_assume(gridDim.x <= 1024u); __builtin_assume(blockIdx.x < gridDim.x);
#define tid  (owave(wv0) * 64 + olane())
#define lane (olane())
#define wave (owave(wv0))
#define G    ((int)gridDim.x)
#define bid  ((int)blockIdx.x)
#define gw   (bid * NWAVES + wave)
#define NGW  (G * NWAVES)
#define gt   (bid * NTHR + tid)
#define NGT  (G * NTHR)
#define KWS_EARLY (kargs_ptr()->ws)
    {
        volatile LAS unsigned* st0 = (volatile LAS unsigned*)((LAS unsigned char*)smem + 131072 + 256);
        if (threadIdx.x < 2) st0[threadIdx.x] = 0u;
        __syncthreads();
        (void)xcd_barrier_post((unsigned*)(KWS_EARLY + WS_BAR), st0, threadIdx.x == 0);
    }
#define GSYNC() do { XcdBarrier b_; b_.bar = (unsigned*)(KWS + WS_BAR); b_.x = xb_xcc_id(); b_.st = (volatile LAS unsigned*)((LAS unsigned char*)smem + 131072 + 256); xcd_barrier(b_, wv0 == 0 && olane() == 0); } while (0)
#define ldsg ((PG8_LAS unsigned char*)smem)
#define part0 ((float*)smem)
#define part1 (part0 + PART_FLOATS)
#define KIN(i) (kargs_ptr()->in[i])
#define KWS    (kargs_ptr()->ws)
#define KOUT   (kargs_ptr()->out)
#define H      (KOUT + O_YP)
#define HS     (KOUT + O_YS)
#define HB0    ((bf16_t*)(KWS + WS_HB0))
#define HB1    ((bf16_t*)(KWS + WS_HB1))
#define ACT    ((bf16_t*)(KWS + WS_ACT))
#define QB     ((bf16_t*)(KWS + WS_QB))
#define KB     ((bf16_t*)(KWS + WS_KB))
#define VB     ((bf16_t*)(KWS + WS_VB))
#define ZF     ((float*)(KWS + WS_ZF))
#define OC     ((bf16_t*)(KWS + WS_OC))
#define LSE    ((float*)(KWS + WS_LSE))
#define MIX    ((bf16_t*)(KWS + WS_MIX))
#define PB     ((bf16_t*)(KWS + WS_PB))
#define UB     ((float*)(KWS + WS_UB))
#define UC     ((float*)(KWS + WS_UC))
#define AB     ((float*)(KWS + WS_AB))
#define AC     ((float*)(KWS + WS_AC))
#define SSQ0   ((float*)(KWS + WS_SSQ0))
#define SSQ1   ((float*)(KWS + WS_SSQ1))
#define PP     ((float*)(KWS + WS_PP))
#define LB     ((float*)(KWS + WS_LB))
#define HSB0   ((bf16_t*)(KWS + WS_HSB0))
#define HSB1   ((bf16_t*)(KWS + WS_HSB1))
#define ACTS   ((bf16_t*)(KWS + WS_ACTS))
#define ZS     ((float*)(KWS + WS_ZS))
#define MIXS   ((bf16_t*)(KWS + WS_MIXS))
#define PSB    ((bf16_t*)(KWS + WS_PSB))
#define SSQS0  ((float*)(KWS + WS_SSQS0))
#define SSQS1  ((float*)(KWS + WS_SSQS1))
#define WLP(l, off) (KWS + WS_W + (size_t)(l) * WL_SIZE + (off))

    {
        float* scr = (float*)(smem + wave * 16384);
        constexpr int I_GU = 16 * 88, I_DN = 44 * 32, I_IN = 16 * 121, I_SQ = 16 * 32, I_PP = 4 * 32;
        constexpr int PER_L = 2 * I_GU + I_DN + I_IN + I_SQ + 2 * I_GU + I_DN + I_SQ + I_PP;
#define TR_DECODE(D, IT) do { const int l_ = (IT) / PER_L; int r_ = (IT) % PER_L; unsigned char* wl_ = WLP(l_, 0); \
            if (r_ < I_GU) { (D) = TrDesc{KIN(9) + (size_t)l_ * DM * FF, KIN(8) + l_ * DM, (bf16_t*)(wl_ + WL_W1GU), DM, FF, 1, r_}; break; } r_ -= I_GU; \
            if (r_ < I_GU) { (D) = TrDesc{KIN(10) + (size_t)l_ * DM * FF, KIN(8) + l_ * DM, (bf16_t*)(wl_ + WL_W1GU), DM, FF, 2, r_}; break; } r_ -= I_GU; \
            if (r_ < I_DN) { (D) = TrDesc{KIN(11) + (size_t)l_ * FF * DM, nullptr, (bf16_t*)(wl_ + WL_W1D), FF, DM, 0, r_}; break; } r_ -= I_DN; \
            if (r_ < I_IN) { (D) = TrDesc{KIN(13) + (size_t)l_ * DM * PW, KIN(12) + l_ * DM, (bf16_t*)(wl_ + WL_WIN), DM, PW, 3, r_}; break; } r_ -= I_IN; \
            if (r_ < I_SQ) { (D) = TrDesc{KIN(19) + (size_t)l_ * DM * DM, nullptr, (bf16_t*)(wl_ + WL_WOUT), DM, DM, 0, r_}; break; } r_ -= I_SQ; \
            if (r_ < I_GU) { (D) = TrDesc{KIN(21) + (size_t)l_ * DM * FF, KIN(20) + l_ * DM, (bf16_t*)(wl_ + WL_W2GU), DM, FF, 1, r_}; break; } r_ -= I_GU; \
            if (r_ < I_GU) { (D) = TrDesc{KIN(22) + (size_t)l_ * DM * FF, KIN(20) + l_ * DM, (bf16_t*)(wl_ + WL_W2GU), DM, FF, 2, r_}; break; } r_ -= I_GU; \
            if (r_ < I_DN) { (D) = TrDesc{KIN(23) + (size_t)l_ * FF * DM, nullptr, (bf16_t*)(wl_ + WL_W2D), FF, DM, 0, r_}; break; } r_ -= I_DN; \
            if (r_ < I_SQ) { (D) = TrDesc{KIN(25) + (size_t)l_ * DM * DM, KIN(24) + l_ * DM, (bf16_t*)(wl_ + WL_WPG), DM, DM, 0, r_}; break; } r_ -= I_SQ; \
            (D) = TrDesc{KIN(26) + (size_t)l_ * 256 * DM, nullptr, (bf16_t*)(wl_ + WL_WPP), 256, DM, 0, r_}; } while (0)
        {
            int it = gw; bool have = it < 2 * PER_L;
            TrDesc cur{}; float wva[32];
            if (have) { TR_DECODE(cur, it); tr_load(cur, wva, lane); }
            while (have) {
                const int itn = it + NGW; const bool hn = itn < 2 * PER_L;
                TrDesc nxt = cur; float wvb[32];
                tr_to_lds(cur, wva, scr, lane);
                if (hn) { TR_DECODE(nxt, itn); tr_load(nxt, wvb, lane); }
                LWAIT();
                tr_readout(cur, scr, lane);
                LWAIT();
                if (hn) {
#pragma unroll
                    for (int i = 0; i < 32; ++i) wva[i] = wvb[i];
                }
                cur = nxt; it = itn; have = hn;
            }
        }
        for (int i = gt; i < 2 * 30720; i += NGT) { const int l = i / 30720, j = i % 30720;
            *(u32x4*)(WLP(l, WL_WIN) + (size_t)PW * DM * 2 + (size_t)j * 16) = (u32x4){0u, 0u, 0u, 0u}; }
        for (int row = gw; row < T + NS; row += NGW) {
            const bool smp = row >= T; const int rr = smp ? row - T : row;
            const float* xr = (smp ? KIN(1) : KIN(0)) + (size_t)rr * DM;
            float* hr = (smp ? HS : H) + (size_t)rr * DM; bf16_t* br = (smp ? HSB0 : HB0) + (size_t)rr * DM;
            float s = 0.f; f32x4 xv[4];
#pragma unroll
            for (int j = 0; j < 4; ++j) xv[j] = *(const f32x4*)(xr + 256 * j + 4 * lane);
#pragma unroll
            for (int j = 0; j < 4; ++j) { const f32x4 v = xv[j]; if (smp) *(f32x4*)(hr + 256 * j + 4 * lane) = v;
                u32x2 w; w.x = cvt_pk_bf16(v[0], v[1]); w.y = cvt_pk_bf16(v[2], v[3]); *(u32x2*)(br + 256 * j + 4 * lane) = w;
                s += (v[0] * v[0] + v[1] * v[1]) + (v[2] * v[2] + v[3] * v[3]); }
            s = wave_sum(s);
            if (smp) { if (lane < 32) SSQS0[rr * 32 + lane] = (lane == 0) ? s : 0.f; }
            else     { if (lane < 16) SSQ0[(size_t)rr * 16 + lane] = (lane == 0) ? s : 0.f; }
        }
        for (int i0 = gt; i0 < 2 * T * 256 / 8; i0 += 4 * NGT) { f32x4 pa[4], pb[4];
#pragma unroll
            for (int q = 0; q < 4; ++q) { const int i = i0 + q * NGT; const float* p = KIN(6) + (size_t)(i < 2 * T * 256 / 8 ? i : i0) * 8; pa[q] = *(const f32x4*)p; pb[q] = *(const f32x4*)(p + 4); }
#pragma unroll
            for (int q = 0; q < 4; ++q) { const int i = i0 + q * NGT; if (i < 2 * T * 256 / 8) *(u32x4*)(PB + (size_t)i * 8) = pg8::pack8(pa[q], pb[q]); } }
        for (int i = gt; i < 2 * NS * 256 / 8; i += NGT) { const float* p = KIN(7) + (size_t)i * 8; const f32x4 a = *(const f32x4*)p, b = *(const f32x4*)(p + 4); *(u32x4*)(PSB + (size_t)i * 8) = pg8::pack8(a, b); }
        if (gt < 512) { const float l0 = KIN(14)[gt], l1 = KIN(14)[512 + gt], m = fmaxf(l0, l1), e0 = __expf(l0 - m), e1 = __expf(l1 - m), s0 = e0 / (e0 + e1), s1 = e1 / (e0 + e1);
            LB[gt] = fmaxf(s0 - s0, 0.f); LB[512 + gt] = fmaxf((s0 + s1) - s0, 0.f); }
    }
    if (KWS == nullptr) grid.sync();
    GSYNC();

    for (int l = 0; l < 2; ++l) {
#define W1GU ((const bf16_t*)WLP(l, WL_W1GU))
#define W1D  ((const bf16_t*)WLP(l, WL_W1D))
#define WIN  ((const bf16_t*)WLP(l, WL_WIN))
#define WOUT ((const bf16_t*)WLP(l, WL_WOUT))
#define W2GU ((const bf16_t*)WLP(l, WL_W2GU))
#define W2D  ((const bf16_t*)WLP(l, WL_W2D))
#define WPG  ((const bf16_t*)WLP(l, WL_WPG))
#define WPP  ((const bf16_t*)WLP(l, WL_WPP))
#define WGU ((const bf16_t*)WLP(l, ffn ? WL_W2GU : WL_W1GU))
#define WD  ((const bf16_t*)WLP(l, ffn ? WL_W2D : WL_W1D))
#define lbl   (LB + l * 512)
#define bnorm (KIN(15) + l * 256)
#define cwg   (KIN(16) + l * 16 * 128)
#define cbias (KIN(17) + l * 128)
#define cnorm (KIN(18) + l * 256)
        for (int ffn = 0; ffn < 2; ++ffn) {
            if (ffn == 1) {
                {
                    pg8::Gemm g{HB1, WIN, T, NPAD, DM}; pg8::StaticOrder S; S.init(T, NPAD, G, bid);
                    pg8::EpiProj E{KWS, KOUT, l, WS_SSQ1, WS_QB, WS_KB, WS_VB, WS_ZF, O_KAP, O_VAP};

#if EN_EPIPROJ
pg8::gemm_phase<pg8::EpiProj, pg8::StaticOrder, true, true>(ldsg, g, S, E, wv0);
#endif

                    __syncthreads();
                    for (int tile = bid; tile < 121; tile += G) {
                        sgemm_tile(HSB1, WIN, DM, 32 * tile, part0, wave, lane);
                        __syncthreads();
                        { const int row = tid >> 4, c0 = (tid & 15) * 2; const float r = row_rinv32(SSQS1, row);
                          ZS[(size_t)row * NPAD + 32 * tile + c0] = part_sum(part0, row, c0) * r; ZS[(size_t)row * NPAD + 32 * tile + c0 + 1] = part_sum(part0, row, c0 + 1) * r; }
                        __syncthreads();
                    }
                }
                GSYNC();
                {

#if EN_ATT
                    {
                        if (wave >= 4) { for (int task = (wave - 4) * G + bid; task < NCH * 4; task += 4 * G) c_task<false>(ZF, (float*)(KWS + WS_FCB), cwg, cbias, UC, AC, cnorm, MIX, task >> 2, task & 3, (float*)(smem + wave * 14336), lane); }
                        const int q = (3 * 8 * 512) / NGW, rm = (3 * 8 * 512) % NGW, g = gw;
                        if (G == 256) attn_units(KWS, bid * 48 + (wave < 4 ? wave * 7 : 28 + (wave - 4) * 5), wave < 4 ? 7 : 5, smem + wave * 14336, lane);
                        else attn_units(KWS, g * q + (g < rm ? g : rm), q + (g < rm ? 1 : 0), smem + wave * 14336, lane);
                    }
#endif

                    __syncthreads();

#if EN_BL
{ int task = bid; do { b_local(ZF, lbl, UB, AB, task >> 2, task & 3, smem, tid, wave, lane); task += G; } while (task < NCHB * 4); }
#endif


#if EN_CL
;
#endif

                    __syncthreads();
                    for (int task = bid; task < 512; task += G) {
                        if (task < 256) s_attn(ZS, KIN(2) + (size_t)l * NS * 2048 * 512, KIN(3) + (size_t)l * NS * 2048 * 512, MIXS, KOUT + O_KAS + (size_t)l * NS * 512, KOUT + O_VAS + (size_t)l * NS * 512,
                                               task >> 3, task & 7, smem, tid, wave, lane);
                        else if (task < 384) s_b(ZS, KIN(4) + (size_t)l * NS * 32768, KOUT + O_SBS + (size_t)l * NS * 32768, lbl, bnorm, MIXS, (task - 256) >> 2, (task - 256) & 3, smem, tid, wave, lane);
                        else s_c(ZS, KIN(5) + (size_t)l * NS * 8192, KOUT + O_SCS + (size_t)l * NS * 8192, cwg, cbias, cnorm, MIXS, (task - 384) >> 2, (task - 384) & 3, smem, tid, wave, lane);
                    }
                }
                GSYNC();
                {
                    float* gA = (float*)smem; float* gU = gA + 8 * 64;
                    for (int task = bid; task < 640; task += G) {
                        const int e = task * 64 + lane; const bool isb = task < 512; const int ee = isb ? e : e - 32768;
                        float* U = isb ? UB : UC; const float* A = isb ? AB : AC; const int usz = isb ? 32768 : 8192, asz = isb ? 512 : 128;
                        const int g = wave, ak = ee >> 6; const bool act = !isb || g < NCHB / 32;
                        float u[32], a[32];
#pragma unroll
                        for (int i = 0; i < 32; ++i) { u[i] = 0.f; a[i] = 1.f; }
                        if (act) {
#pragma unroll
                            for (int i = 0; i < 32; ++i) { u[i] = U[(size_t)(32 * g + i) * usz + ee]; a[i] = A[(size_t)(32 * g + i) * asz + ak]; }
                        }
                        float sl = 0.f, c = 1.f;
#pragma unroll
                        for (int i = 0; i < 32; ++i) { const float ui = u[i], ai = a[i]; u[i] = sl; a[i] = c; sl = ai * sl + ui; c *= ai; }
                        gA[g * 64 + lane] = c; gU[g * 64 + lane] = sl;
                        __syncthreads();
                        float carry = 0.f;
                        for (int j = 0; j < g; ++j) carry = gA[j * 64 + lane] * carry + gU[j * 64 + lane];
#pragma unroll
                        for (int i = 0; i < 32; ++i) { if (act) U[(size_t)(32 * g + i) * usz + ee] = a[i] * carry + u[i]; }
                        if (g == 7) (isb ? KOUT + O_SBP + (size_t)l * 32768 : KOUT + O_SCP + (size_t)l * 8192)[ee] = c * carry + sl;
                        __syncthreads();
                    }
                }
                GSYNC();
                {

#if EN_BO
{ int task = bid; do { b_output(ZF, lbl, UB, bnorm, MIX, task >> 2, task & 3, smem, tid, wave, lane); task += G; } while (task < NCHB * 4); }
#endif


#if EN_CO
if (wave < 4 || G != 256) for (int task = wave * G + bid; task < NCH * 4; task += NGW) c_task<true>(ZF, (float*)(KWS + WS_FCB), cwg, cbias, UC, AC, cnorm, MIX, task >> 2, task & 3, (float*)(smem + wave * 14336), lane);
#endif

                    const bool mrg_half = (G == 256);
                    if (!mrg_half || wave >= 4) {
                        const int istr = mrg_half ? G * 256 : NGT;
                        for (int i0 = mrg_half ? bid * 256 + (tid - 256) : gt; i0 < T * 64; i0 += 4 * istr) {
                            float lw[4][3]; u32x4 va[4], vb[4], vc[4];
#pragma unroll
                            for (int q = 0; q < 4; ++q) { const int i = i0 + q * istr; const bool ok = i < T * 64; const int ii = ok ? i : i0;
                                const int t = ii >> 6, h = (ii >> 3) & 7, d8 = ii & 7; const size_t off = (size_t)t * 512 + h * 64 + d8 * 8;
                                lw[q][0] = LSE[((size_t)0 * T + t) * 8 + h]; lw[q][1] = LSE[((size_t)1 * T + t) * 8 + h]; lw[q][2] = LSE[((size_t)2 * T + t) * 8 + h];
                                va[q] = *(const u32x4*)(OC + off); vb[q] = *(const u32x4*)(OC + (size_t)T * 512 + off); vc[q] = *(const u32x4*)(OC + (size_t)2 * T * 512 + off); }
#pragma unroll
                            for (int q = 0; q < 4; ++q) { const int i = i0 + q * istr; if (i < T * 64) {
                                const int t = i >> 6, h = (i >> 3) & 7, d8 = i & 7;
                                const float l0 = lw[q][0], l1 = lw[q][1], l2 = lw[q][2];
                                const float m = fmaxf(l0, fmaxf(l1, l2)); float w0 = __expf(l0 - m), w1 = __expf(l1 - m), w2 = __expf(l2 - m); const float inv = 1.0f / (w0 + w1 + w2); w0 *= inv; w1 *= inv; w2 *= inv;
                                const u32x4 a = va[q], b = vb[q], c = vc[q];
                                u32x4 o;
#pragma unroll
                                for (int j = 0; j < 4; ++j) {
                                    const float lo = w0 * __uint_as_float(a[j] << 16) + w1 * __uint_as_float(b[j] << 16) + w2 * __uint_as_float(c[j] << 16);
                                    const float hi = w0 * __uint_as_float(a[j] & 0xffff0000u) + w1 * __uint_as_float(b[j] & 0xffff0000u) + w2 * __uint_as_float(c[j] & 0xffff0000u);
                                    o[j] = cvt_pk_bf16(lo, hi);
                                }
                                *(u32x4*)(MIX + (size_t)t * 1024 + h * 64 + d8 * 8) = o; } }
                        }
                    }
                }
                GSYNC();
                {
                    pg8::Gemm g{MIX, WOUT, T, DM, DM}; pg8::StaticOrder S; S.init(T, DM, G, bid);
                    pg8::EpiRes E{H, H, HB0, SSQ0, 1.0f};

#if EN_EPIRES
pg8::gemm_phase<pg8::EpiRes, pg8::StaticOrder, true, true>(ldsg, g, S, E, wv0);
#endif

                    __syncthreads();
                    for (int tile = bid; tile < 32; tile += G) {
                        sgemm_tile(MIXS, WOUT, DM, 32 * tile, part0, wave, lane);
                        __syncthreads();
                        { const int row = tid >> 4, c0 = (tid & 15) * 2; float* hp = HS + (size_t)row * DM + 32 * tile + c0;
                          const float h0 = hp[0] + part_sum(part0, row, c0), h1 = hp[1] + part_sum(part0, row, c0 + 1); hp[0] = h0; hp[1] = h1;
                          *(unsigned*)(HSB0 + (size_t)row * DM + 32 * tile + c0) = cvt_pk_bf16(h0, h1);
                          float ss = h0 * h0 + h1 * h1;
#pragma unroll
                          for (int o = 1; o < 16; o <<= 1) ss += __shfl_xor(ss, o);
                          if ((tid & 15) == 0) SSQS0[row * 32 + tile] = ss; }
                        __syncthreads();
                    }
                }
                GSYNC();
            }

            {
                pg8::Gemm g{HB0, WGU, T, 2 * FF, DM}; pg8::StaticOrder S; S.init(T, 2 * FF, G, bid);
                pg8::EpiAct E{SSQ0, ACT};

#if EN_EPIACT
pg8::gemm_phase<pg8::EpiAct, pg8::StaticOrder, true, true>(ldsg, g, S, E, wv0);
#endif

                __syncthreads();
                if (ffn == 1) {
                    pg8::Gemm g2{PB + (size_t)l * T * 256, WPP, T, DM, 256}; pg8::HalfOrder S2; S2.init(G, bid);
                    pg8::EpiStash E2{PP};
                    pg8::gemm_phase<pg8::EpiStash, pg8::HalfOrder, true, true>(ldsg, g2, S2, E2, wv0);
                    __syncthreads();
                }

                for (int pt = (G == 256) ? (bid >= 128 ? bid - 128 : 1 << 20) : bid; pt < 88; pt += G) {
                    const int n0 = 256 * (pt >> 2) + 32 * (pt & 3);
                    sgemm_tile(HSB0, WGU, DM, n0, part0, wave, lane);
                    sgemm_tile(HSB0, WGU, DM, n0 + 128, part1, wave, lane);
                    __syncthreads();
                    { const int row = tid >> 4, c0 = (tid & 15) * 2; const float r = row_rinv32(SSQS0, row);
                      const float g0 = part_sum(part0, row, c0) * r, g1 = part_sum(part0, row, c0 + 1) * r, u0 = part_sum(part1, row, c0) * r, u1 = part_sum(part1, row, c0 + 1) * r;
                      *(unsigned*)(ACTS + (size_t)row * FF + 32 * pt + c0) = cvt_pk_bf16(fsilu(g0) * u0, fsilu(g1) * u1); }
                    __syncthreads();
                }
            }
            GSYNC();
            {
                pg8::Gemm g{ACT, WD, T, DM, FF}; pg8::StaticOrder S; S.init(T, DM, G, bid);
                pg8::EpiRes E{(l == 0 && ffn == 0) ? KIN(0) : (const float*)H, H, HB1, SSQ1, 0.5f};

#if EN_EPIRES
pg8::gemm_phase<pg8::EpiRes, pg8::StaticOrder, true, true>(ldsg, g, S, E, wv0);
#endif

                __syncthreads();
                for (int tile = bid; tile < 32; tile += G) {
                    sgemm_tile(ACTS, WD, FF, 32 * tile, part0, wave, lane);
                    __syncthreads();
                    { const int row = tid >> 4, c0 = (tid & 15) * 2; float* hp = HS + (size_t)row * DM + 32 * tile + c0;
                      const float h0 = hp[0] + 0.5f * part_sum(part0, row, c0), h1 = hp[1] + 0.5f * part_sum(part0, row, c0 + 1); hp[0] = h0; hp[1] = h1;
                      *(unsigned*)(HSB1 + (size_t)row * DM + 32 * tile + c0) = cvt_pk_bf16(h0, h1);
                      float ss = h0 * h0 + h1 * h1;
#pragma unroll
                      for (int o = 1; o < 16; o <<= 1) ss += __shfl_xor(ss, o);
                      if ((tid & 15) == 0) SSQS1[row * 32 + tile] = ss; }
                    __syncthreads();
                }
            }
            GSYNC();
        }
        {
            { pg8::Gemm g{HB1, WPG, T, DM, DM}; pg8::StaticOrder S; S.init(T, DM, G, bid);
              pg8::EpiPle E{SSQ1, PP, H, HB0, SSQ0};

#if EN_EPIPLE
pg8::gemm_phase<pg8::EpiPle, pg8::StaticOrder, true, true>(ldsg, g, S, E, wv0);
#endif
 }
            __syncthreads();
            for (int tile = bid; tile < 32; tile += G) {
                sgemm_tile(PSB + (size_t)l * NS * 256, WPP, 256, 32 * tile, part0, wave, lane);
                sgemm_tile(HSB1, WPG, DM, 32 * tile, part1, wave, lane);
                __syncthreads();
                { const int row = tid >> 4, c0 = (tid & 15) * 2; float* hp = HS + (size_t)row * DM + 32 * tile + c0; const float r = row_rinv32(SSQS1, row);
                  const float h0 = hp[0] + fsigmoid(part_sum(part1, row, c0) * r) * part_sum(part0, row, c0), h1 = hp[1] + fsigmoid(part_sum(part1, row, c0 + 1) * r) * part_sum(part0, row, c0 + 1);
                  hp[0] = h0; hp[1] = h1;
                  *(unsigned*)(HSB0 + (size_t)row * DM + 32 * tile + c0) = cvt_pk_bf16(h0, h1);
                  float ss = h0 * h0 + h1 * h1;
#pragma unroll
                  for (int o = 1; o < 16; o <<= 1) ss += __shfl_xor(ss, o);
                  if ((tid & 15) == 0) SSQS0[row * 32 + tile] = ss; }
                __syncthreads();
            }
        }
        GSYNC();
    }
    {
        f32x4 gv[4];
#pragma unroll
        for (int j = 0; j < 4; ++j) gv[j] = *(const f32x4*)(KIN(27) + 256 * j + 4 * lane);
        for (int row0 = gw; row0 < T + NS; row0 += 4 * NGW) {
            f32x4 v[4][4]; float r[4];
#pragma unroll
            for (int q = 0; q < 4; ++q) { const int row = row0 + q * NGW; const bool ok = row < T + NS; const int rw = ok ? row : row0;
                const bool smp = rw >= T; const int rr = smp ? rw - T : rw;
                const float* hr = (smp ? HS : H) + (size_t)rr * DM;
#pragma unroll
                for (int j = 0; j < 4; ++j) v[q][j] = *(const f32x4*)(hr + 256 * j + 4 * lane);
                r[q] = smp ? row_rinv32(SSQS0, rr) : pg8::row_rinv16(SSQ0, rr); }
#pragma unroll
            for (int q = 0; q < 4; ++q) { const int row = row0 + q * NGW; if (row < T + NS) {
                const bool smp = row >= T; const int rr = smp ? row - T : row;
                float* hr = (smp ? HS : H) + (size_t)rr * DM;
#pragma unroll
                for (int j = 0; j < 4; ++j) *(f32x4*)(hr + 256 * j + 4 * lane) = v[q][j] * r[q] * gv[j]; } }
        }
    }
}

extern "C" void kernel_launch(void* const* d_in, const int* in_sizes, int n_in, void* d_out, int out_size, void* d_ws, size_t ws_size, hipStream_t stream) {
    static int grid = 0;
    if (grid == 0) {
        if (n_in != 28 || (size_t)out_size != O_END || ws_size < WS_END) { fprintf(stderr, "kernel_launch: unexpected shapes (n_in %d out %d ws %zu need %zu)\n", n_in, out_size, ws_size, (size_t)WS_END); grid = -1; return; }
        int dev = 0, cus = 0, per_cu = 0;
        if (hipGetDevice(&dev) != hipSuccess || hipDeviceGetAttribute(&cus, hipDeviceAttributeMultiprocessorCount, dev) != hipSuccess) { grid = -1; return; }
        if (hipFuncSetAttribute((const void*)mega_fwd, hipFuncAttributeMaxDynamicSharedMemorySize, LDS_BYTES) != hipSuccess) { fprintf(stderr, "kernel_launch: hipFuncSetAttribute failed\n"); grid = -1; return; }
        if (hipOccupancyMaxActiveBlocksPerMultiprocessor(&per_cu, (const void*)mega_fwd, NTHR, LDS_BYTES) != hipSuccess || per_cu < 1) { fprintf(stderr, "kernel_launch: occupancy query failed (%d)\n", per_cu); (void)hipGetLastError(); per_cu = 1; }
        grid = cus * 1;
        if (grid > cus * per_cu) grid = cus * per_cu;
    }
    if (grid < 0) return;
    if (hipMemsetAsync((unsigned char*)d_ws + WS_BAR, 0, WS_BAR_BYTES, stream) != hipSuccess) { fprintf(stderr, "kernel_launch: memset failed\n"); return; }
    Args a{};
    for (int i = 0; i < 28; ++i) a.in[i] = (const float*)d_in[i];
    a.out = (float*)d_out; a.ws = (unsigned char*)d_ws;
    void* kargs[] = {&a};
    hipError_t e = hipLaunchCooperativeKernel((const void*)mega_fwd, dim3(grid), dim3(NTHR), kargs, LDS_BYTES, stream);
    if (e != hipSuccess) fprintf(stderr, "kernel_launch: cooperative launch failed: %s (grid %d)\n", hipGetErrorString(e), grid);
}
```

```cpp
#include <hip/hip_runtime.h>
#include <hip/hip_cooperative_groups.h>
#include <cstdio>
#include <cstdint>
namespace cg = cooperative_groups;
namespace pg8 {
#define PG8_LAS __attribute__((address_space(3)))
typedef unsigned short bf16_t;
typedef short bf16x8 __attribute__((ext_vector_type(8)));
typedef float f32x4 __attribute__((ext_vector_type(4)));
typedef unsigned u32x4 __attribute__((ext_vector_type(4)));
constexpr int BM = 256, BK = 64, HALF = 128, HTB = HALF * BK * 2  , STAGE_BYTES = 8 * HTB, NXCD = 8, WGM = 8;

__host__ __device__ __forceinline__ int lds_byte(int r, int c) { const int st = (r >> 4) * 2 + (c >> 5), rr = r & 15, cc = c & 31, ob = rr * 64 + cc * 2; return st * 1024 + (ob ^ (((ob >> 9) & 1) << 5)); }
__host__ __device__ __forceinline__ void stage_rc(int b, int& R, int& C) { const int st = b / 1024, sb = b % 1024, swz = sb ^ (((sb >> 9) & 1) << 5); R = (st >> 1) * 16 + swz / 64; C = (st & 1) * 32 + (swz % 64) / 2; }
__host__ __device__ __forceinline__ int perm32(int rho) { const int n = rho >> 4, i = rho & 15; return 8 * (i >> 2) + 4 * n + (i & 3); }

struct Unit { int pm, pn; };
struct Gemm { const bf16_t* A; const bf16_t* Bt; int M, N, K; };

struct StaticOrder {
    int nM, nN, nwg, G, c;
    __host__ __device__ void init(int M, int N, int G_, int c_) { nM = M / BM; nN = N / BM; nwg = nM * nN; G = G_; c = c_; }
    __host__ __device__ bool next(int i, Unit& u) const {
        const long L = (long)i * G + c; if (L >= nwg) return false;
        int wgid = (int)L; { const int q = nwg / NXCD, r = nwg % NXCD, xcd = wgid % NXCD, off = wgid / NXCD; wgid = (xcd < r ? xcd * (q + 1) : r * (q + 1) + (xcd - r) * q) + off; }
        const int nig = WGM * nN, gid = wgid / nig, fm = gid * WGM, gsz = (nM - fm) < WGM ? (nM - fm) : WGM;
        u.pm = fm + ((wgid % nig) % gsz); u.pn = (wgid % nig) / gsz; return true;
    }
    __device__ __forceinline__ void a_ready(const Unit&) const {}
    __device__ __forceinline__ void done(const Unit&) const {}
};

struct HalfOrder {
    int c, nblk;
    __host__ __device__ void init(int G_, int c_) { nblk = G_ - G_ / 2; c = c_ - G_ / 2; }
    __host__ __device__ bool next(int i, Unit& u) const { if (c < 0) return false; const int L = i * nblk + c; if (L >= 256) return false; u.pm = L >> 2; u.pn = L & 3; return true; }
    __device__ __forceinline__ void a_ready(const Unit&) const {}
    __device__ __forceinline__ void done(const Unit&) const {}
};

__device__ __forceinline__ unsigned cvt_pk_bf16(float lo, float hi) { unsigned r; asm volatile("v_cvt_pk_bf16_f32 %0, %1, %2" : "=v"(r) : "v"(lo), "v"(hi)); return r; }

typedef float f32x16 __attribute__((ext_vector_type(16)));
constexpr float RMS_EPS = 1e-6f;
__device__ __forceinline__ float fsigmoid(float x) { return __builtin_amdgcn_rcpf(1.0f + __builtin_amdgcn_exp2f(x * -1.4426950408889634f)); }
__device__ __forceinline__ float fsilu(float x) { return x * __builtin_amdgcn_rcpf(1.0f + __builtin_amdgcn_exp2f(x * -1.4426950408889634f)); }
__device__ __forceinline__ float row_rinv16(const float* ssq, int row) {
    const f32x4* p = (const f32x4*)(ssq + (size_t)row * 16);
    const f32x4 a = p[0], b = p[1], c = p[2], d = p[3];
    const float s = ((a[0] + a[1]) + (a[2] + a[3])) + ((b[0] + b[1]) + (b[2] + b[3])) + ((c[0] + c[1]) + (c[2] + c[3])) + ((d[0] + d[1]) + (d[2] + d[3]));
    return rsqrtf(s * (1.0f / 1024.0f) + RMS_EPS);
}
__device__ __forceinline__ u32x4 pack8(const f32x4 a, const f32x4 b) {
    u32x4 w; w.x = cvt_pk_bf16(a[0], a[1]); w.y = cvt_pk_bf16(a[2], a[3]); w.z = cvt_pk_bf16(b[0], b[1]); w.w = cvt_pk_bf16(b[2], b[3]); return w;
}

template <int NB  >
__device__ __forceinline__ void rinv8(const float* ssq, int row0, float (&r)[8]) {
#pragma unroll
    for (int b = 0; b < 8 / NB; ++b) {
        f32x4 p[NB][4];
#pragma unroll
        for (int mm = 0; mm < NB; ++mm) { const int i = b * NB + mm, ai = i >> 2, m = i & 3;
#pragma unroll
            for (int q = 0; q < 4; ++q) p[mm][q] = *(const f32x4*)(ssq + (size_t)(row0 + ai * HALF + m * 16) * 16 + 4 * q); }
#pragma unroll
        for (int mm = 0; mm < NB; ++mm) {
            const f32x4 a = p[mm][0], bb = p[mm][1], c = p[mm][2], d = p[mm][3];
            const float s = ((a[0] + a[1]) + (a[2] + a[3])) + ((bb[0] + bb[1]) + (bb[2] + bb[3])) + ((c[0] + c[1]) + (c[2] + c[3])) + ((d[0] + d[1]) + (d[2] + d[3]));
            r[b * NB + mm] = rsqrtf(s * (1.0f / 1024.0f) + RMS_EPS);
        }
        asm volatile("" ::: "memory");
    }
}

struct EpiAct {
    static constexpr bool PERM = true, AFTER_DRAIN = false;
    const float* ssq; bf16_t* act;
    __device__ __forceinline__ void operator()(const f32x4 (&acc)[2][2][4][2], const Unit& u, int wr, int wc, int fr, int fq) const {
        const int colo = u.pn * 128 + wc * 32 + 8 * fq;
        f32x4 pc[4];
#pragma unroll
        for (int q = 0; q < 4; ++q) pc[q] = *(const f32x4*)(ssq + (size_t)(u.pm * BM + wr * 64 + fr) * 16 + 4 * q);
#pragma unroll
        for (int ai = 0; ai < 2; ++ai)
#pragma unroll
            for (int m = 0; m < 4; ++m) {
                const int row = u.pm * BM + ai * HALF + wr * 64 + m * 16 + fr;
                f32x4 pn[4];
                { const int g1 = (ai * 4 + m + 1) & 7, rown = u.pm * BM + (g1 >> 2) * HALF + wr * 64 + (g1 & 3) * 16 + fr;
#pragma unroll
                  for (int q = 0; q < 4; ++q) pn[q] = *(const f32x4*)(ssq + (size_t)rown * 16 + 4 * q); }
                const float r = rsqrtf((((pc[0][0] + pc[0][1]) + (pc[0][2] + pc[0][3])) + ((pc[1][0] + pc[1][1]) + (pc[1][2] + pc[1][3])) + ((pc[2][0] + pc[2][1]) + (pc[2][2] + pc[2][3])) + ((pc[3][0] + pc[3][1]) + (pc[3][2] + pc[3][3]))) * (1.0f / 1024.0f) + RMS_EPS);
#pragma unroll
                for (int q = 0; q < 4; ++q) pc[q] = pn[q];
                f32x4 o[2];
#pragma unroll
                for (int n = 0; n < 2; ++n) {
                    const f32x4 g = acc[ai][0][m][n] * r, up = acc[ai][1][m][n] * r;
#pragma unroll
                    for (int j = 0; j < 4; ++j) o[n][j] = fsilu(g[j]) * up[j];
                }
                *(u32x4*)(act + (size_t)row * 2816 + colo) = pack8(o[0], o[1]);
                asm volatile("" ::: "memory");
            }
    }
};
struct EpiRes {
    static constexpr bool PERM = true, AFTER_DRAIN = false;
    const float* hin; float* h; bf16_t* hb; float* ssq_out; float scale;
    __device__ __forceinline__ void operator()(const f32x4 (&acc)[2][2][4][2], const Unit& u, int wr, int wc, int fr, int fq) const {
#pragma unroll
        for (int ai = 0; ai < 2; ++ai) {
            f32x4 hv[4][2][2];
#pragma unroll
            for (int m = 0; m < 4; ++m)
#pragma unroll
                for (int bj = 0; bj < 2; ++bj) { const float* hp = hin + (size_t)(u.pm * BM + ai * HALF + wr * 64 + m * 16 + fr) * 1024 + u.pn * BM + bj * HALF + wc * 32 + 8 * fq;
                    hv[m][bj][0] = *(const f32x4*)hp; hv[m][bj][1] = *(const f32x4*)(hp + 4); }
#pragma unroll
            for (int m = 0; m < 4; ++m) {
                const int row = u.pm * BM + ai * HALF + wr * 64 + m * 16 + fr;
                float ss = 0.f;
#pragma unroll
                for (int bj = 0; bj < 2; ++bj) {
                    const int col0 = u.pn * BM + bj * HALF + wc * 32 + 8 * fq;
                    float* hp = h + (size_t)row * 1024 + col0;
                    const f32x4 h0 = hv[m][bj][0] + acc[ai][bj][m][0] * scale, h1 = hv[m][bj][1] + acc[ai][bj][m][1] * scale;
                    *(f32x4*)hp = h0; *(f32x4*)(hp + 4) = h1;
                    *(u32x4*)(hb + (size_t)row * 1024 + col0) = pack8(h0, h1);
                    ss += (h0[0] * h0[0] + h0[1] * h0[1]) + (h0[2] * h0[2] + h0[3] * h0[3]) + (h1[0] * h1[0] + h1[1] * h1[1]) + (h1[2] * h1[2] + h1[3] * h1[3]);
                }
                ss += __shfl_xor(ss, 16); ss += __shfl_xor(ss, 32);
                if (fq == 0) ssq_out[(size_t)row * 16 + u.pn * 4 + wc] = ss;
            }
            asm volatile("" ::: "memory");
        }
    }
};
struct EpiStash {
    static constexpr bool PERM = true, AFTER_DRAIN = false;
    float* pp;
    __device__ __forceinline__ void operator()(const f32x4 (&acc)[2][2][4][2], const Unit& u, int wr, int wc, int fr, int fq) const {
#pragma unroll
        for (int ai = 0; ai < 2; ++ai)
#pragma unroll
            for (int m = 0; m < 4; ++m) {
                const int row = u.pm * BM + ai * HALF + wr * 64 + m * 16 + fr;
#pragma unroll
                for (int bj = 0; bj < 2; ++bj) {
                    float* p = pp + (size_t)row * 1024 + u.pn * BM + bj * HALF + wc * 32 + 8 * fq;
                    *(f32x4*)p = acc[ai][bj][m][0]; *(f32x4*)(p + 4) = acc[ai][bj][m][1];
                }
                asm volatile("" ::: "memory");
            }
    }
};
struct EpiPle {
    static constexpr bool PERM = true, AFTER_DRAIN = false;
    const float* ssq_in; const float* pp; float* h; bf16_t* hb; float* ssq_out;
    __device__ __forceinline__ void operator()(const f32x4 (&acc)[2][2][4][2], const Unit& u, int wr, int wc, int fr, int fq) const {
        f32x4 pc[4];
#pragma unroll
        for (int q = 0; q < 4; ++q) pc[q] = *(const f32x4*)(ssq_in + (size_t)(u.pm * BM + wr * 64 + fr) * 16 + 4 * q);
#pragma unroll
        for (int ai = 0; ai < 2; ++ai)
#pragma unroll
            for (int m = 0; m < 4; ++m) {
                const int row = u.pm * BM + ai * HALF + wr * 64 + m * 16 + fr;
                f32x4 pn[4];
                { const int g1 = (ai * 4 + m + 1) & 7, rown = u.pm * BM + (g1 >> 2) * HALF + wr * 64 + (g1 & 3) * 16 + fr;
#pragma unroll
                  for (int q = 0; q < 4; ++q) pn[q] = *(const f32x4*)(ssq_in + (size_t)rown * 16 + 4 * q); }
                f32x4 hv[2][2], pv[2][2];
#pragma unroll
                for (int bj = 0; bj < 2; ++bj) { const size_t off = (size_t)row * 1024 + u.pn * BM + bj * HALF + wc * 32 + 8 * fq;
                    hv[bj][0] = *(const f32x4*)(h + off); hv[bj][1] = *(const f32x4*)(h + off + 4); pv[bj][0] = *(const f32x4*)(pp + off); pv[bj][1] = *(const f32x4*)(pp + off + 4); }
                const float r = rsqrtf((((pc[0][0] + pc[0][1]) + (pc[0][2] + pc[0][3])) + ((pc[1][0] + pc[1][1]) + (pc[1][2] + pc[1][3])) + ((pc[2][0] + pc[2][1]) + (pc[2][2] + pc[2][3])) + ((pc[3][0] + pc[3][1]) + (pc[3][2] + pc[3][3]))) * (1.0f / 1024.0f) + RMS_EPS);
#pragma unroll
                for (int q = 0; q < 4; ++q) pc[q] = pn[q];
                float ss = 0.f;
#pragma unroll
                for (int bj = 0; bj < 2; ++bj) {
                    const int col0 = u.pn * BM + bj * HALF + wc * 32 + 8 * fq;
                    float* hp = h + (size_t)row * 1024 + col0;
                    f32x4 h0 = hv[bj][0], h1 = hv[bj][1];
#pragma unroll
                    for (int j = 0; j < 4; ++j) { h0[j] += fsigmoid(acc[ai][bj][m][0][j] * r) * pv[bj][0][j]; h1[j] += fsigmoid(acc[ai][bj][m][1][j] * r) * pv[bj][1][j]; }
                    *(f32x4*)hp = h0; *(f32x4*)(hp + 4) = h1;
                    *(u32x4*)(hb + (size_t)row * 1024 + col0) = pack8(h0, h1);
                    ss += (h0[0] * h0[0] + h0[1] * h0[1]) + (h0[2] * h0[2] + h0[3] * h0[3]) + (h1[0] * h1[0] + h1[1] * h1[1]) + (h1[2] * h1[2] + h1[3] * h1[3]);
                }
                ss += __shfl_xor(ss, 16); ss += __shfl_xor(ss, 32);
                if (fq == 0) ssq_out[(size_t)row * 16 + u.pn * 4 + wc] = ss;
                asm volatile("" ::: "memory");
            }
    }
};
struct EpiProj {
    static constexpr bool PERM = true, AFTER_DRAIN = false;
    unsigned char* ws; float* outp; int layer;
    size_t o_ssq, o_qb, o_kb, o_vb, o_zf, o_kap, o_vap;
    __device__ __forceinline__ void operator()(const f32x4 (&acc)[2][2][4][2], const Unit& u, int wr, int wc, int fr, int fq) const {
        const int c = wc * 32 + 8 * fq;
        const float* ssq = (const float*)(ws + o_ssq); bf16_t* Qb = (bf16_t*)(ws + o_qb); bf16_t* Kb = (bf16_t*)(ws + o_kb); bf16_t* Vb = (bf16_t*)(ws + o_vb);
        float* ZF = (float*)(ws + o_zf);
        float* kout = outp + o_kap + (size_t)layer * 2048 * 512; float* vout = outp + o_vap + (size_t)layer * 2048 * 512;
        f32x4 pc[4];
#pragma unroll
        for (int q = 0; q < 4; ++q) pc[q] = *(const f32x4*)(ssq + (size_t)(u.pm * BM + wr * 64 + fr) * 16 + 4 * q);
#pragma unroll
        for (int ai = 0; ai < 2; ++ai)
#pragma unroll
            for (int m = 0; m < 4; ++m) {
                const int row = u.pm * BM + ai * HALF + wr * 64 + m * 16 + fr;
                f32x4 pn[4];
                { const int g1 = (ai * 4 + m + 1) & 7, rown = u.pm * BM + (g1 >> 2) * HALF + wr * 64 + (g1 & 3) * 16 + fr;
#pragma unroll
                  for (int q = 0; q < 4; ++q) pn[q] = *(const f32x4*)(ssq + (size_t)rown * 16 + 4 * q); }
                const float r = rsqrtf((((pc[0][0] + pc[0][1]) + (pc[0][2] + pc[0][3])) + ((pc[1][0] + pc[1][1]) + (pc[1][2] + pc[1][3])) + ((pc[2][0] + pc[2][1]) + (pc[2][2] + pc[2][3])) + ((pc[3][0] + pc[3][1]) + (pc[3][2] + pc[3][3]))) * (1.0f / 1024.0f) + RMS_EPS);
#pragma unroll
                for (int q = 0; q < 4; ++q) pc[q] = pn[q];
#pragma unroll
                for (int bj = 0; bj < 2; ++bj) {
                    const int zc = u.pn * BM + bj * HALF;
                    f32x4 v0 = acc[ai][bj][m][0] * r, v1 = acc[ai][bj][m][1] * r;
                    if (zc < 1536) {
                        const int which = zc >> 9, cc = (zc & 511) + c;
                        if (which == 0) { v0 = v0 * 0.18033688011112042f; v1 = v1 * 0.18033688011112042f; }
                        bf16_t* dst = (which == 0 ? Qb : (which == 1 ? Kb : Vb)) + (size_t)row * 512 + cc;
                        *(u32x4*)dst = pack8(v0, v1);
                        if (which > 0 && row >= 16384 - 2048) {
                            float* o = (which == 1 ? kout : vout) + (size_t)(row - (16384 - 2048)) * 512 + cc;
                            *(f32x4*)o = v0; *(f32x4*)(o + 4) = v1;
                        }
                    } else {
                        float* o = ZF + (size_t)row * 2560 + (zc - 1536) + c;
                        *(f32x4*)o = v0; *(f32x4*)(o + 4) = v1;
                    }
                }
                asm volatile("" ::: "memory");
            }
    }
};
template <class Epi, class Sched, bool ALIGN_EPI = false, bool SP2 = false>
__device__ __forceinline__ void gemm_phase(PG8_LAS unsigned char* lds, const Gemm g, const Sched& S, const Epi& E, const int wid_in) {
    int tid_o = wid_in * 64 + (int)__builtin_amdgcn_mbcnt_hi(~0u, __builtin_amdgcn_mbcnt_lo(~0u, 0u)); asm volatile("" : "+v"(tid_o));
    const int tid = tid_o, wid = __builtin_amdgcn_readfirstlane(tid >> 6), lane = tid & 63, wr = wid >> 2, wc = wid & 3, fr = lane & 15, fq = lane >> 4;
    const int K = g.K, nt = K / BK;
    unsigned voffA[2], voffB[2];
#pragma unroll
    for (int i = 0; i < 2; ++i) { int R, C; stage_rc(tid * 16 + i * 8192, R, C); const int Rb = Epi::PERM ? ((R & ~31) + perm32(R & 31)) : R;
        voffA[i] = (unsigned)(R * K + C) * 2u; voffB[i] = (unsigned)(Rb * K + C) * 2u; }
    const size_t kstep = (size_t)(BK * 2);
    const size_t hstep = (size_t)HALF * K * 2;
    const size_t tstep = 2 * hstep;
    const unsigned ldsw = (unsigned)wid * 1024u;
    const int aoff = lds_byte(wr * 64 + fr, fq * 8), boff = lds_byte(wc * 32 + fr, fq * 8);
#define PG8_SA(b, h) (((b) * 2 + (h)) * HTB)
#define PG8_SB(b, h) ((4 + (b) * 2 + (h)) * HTB)
#define PG8_STAGE(bufoff, gbase, voff) do { _Pragma("unroll") for (int _i = 0; _i < 2; ++_i) \
        __builtin_amdgcn_global_load_lds((const unsigned*)((const char*)(gbase) + (voff)[_i]), (PG8_LAS unsigned*)(lds + (bufoff) + ldsw + _i * 8192), 16, 0, 0); } while (0)
#define PG8_LDA(dst, b, h) do { _Pragma("unroll") for (int m = 0; m < 4; ++m) _Pragma("unroll") for (int k = 0; k < 2; ++k) dst[m][k] = *(const PG8_LAS bf16x8*)(lds + PG8_SA(b, h) + aoff + m * 2048 + k * 1024); } while (0)
#define PG8_LDB(dst, b, h) do { _Pragma("unroll") for (int n = 0; n < 2; ++n) _Pragma("unroll") for (int k = 0; k < 2; ++k) dst[n][k] = *(const PG8_LAS bf16x8*)(lds + PG8_SB(b, h) + boff + n * 2048 + k * 1024); } while (0)
#define PG8_MMA(ai, bj, At, Bt) do { __builtin_amdgcn_s_setprio(1); _Pragma("unroll") for (int m = 0; m < 4; ++m) _Pragma("unroll") for (int n = 0; n < 2; ++n) _Pragma("unroll") for (int k = 0; k < 2; ++k) \
        acc[ai][bj][m][n] = __builtin_amdgcn_mfma_f32_16x16x32_bf16(Bt[n][k], At[m][k], acc[ai][bj][m][n], 0, 0, 0); __builtin_amdgcn_s_setprio(0); } while (0)
#define PG8_WAIT_V(n) asm volatile("s_waitcnt vmcnt(" #n ")" ::: "memory")
#define PG8_WAIT_L(n) asm volatile("s_waitcnt lgkmcnt(" #n ")" ::: "memory")
#define PG8_BAR __builtin_amdgcn_s_barrier()
#define PG8_SCHED __builtin_amdgcn_sched_barrier(0)
    Unit cur, nxt; int ui = 0;
    if (!S.next(0, cur)) return;
    f32x4 acc[2][2][4][2];
#pragma unroll
    for (int a = 0; a < 2; ++a)
#pragma unroll
        for (int b = 0; b < 2; ++b)
#pragma unroll
            for (int m = 0; m < 4; ++m)
#pragma unroll
                for (int n = 0; n < 2; ++n) acc[a][b][m][n] = (f32x4){0.f, 0.f, 0.f, 0.f};
    bf16x8 At[4][2], B0[2][2], B1[2][2];
    const char* cA = (const char*)g.A + (size_t)cur.pm * tstep; const char* cB = (const char*)g.Bt + (size_t)cur.pn * tstep;
    S.a_ready(cur);
    if constexpr (SP2) {
        PG8_STAGE(PG8_SB(0, 0), cB, voffB); PG8_STAGE(PG8_SB(0, 1), cB + hstep, voffB); PG8_STAGE(PG8_SA(0, 0), cA, voffA); PG8_STAGE(PG8_SA(0, 1), cA + hstep, voffA);
        if (wr == 1) PG8_BAR;
        PG8_WAIT_V(2); PG8_BAR;
        PG8_STAGE(PG8_SB(1, 0), cB + kstep, voffB); PG8_STAGE(PG8_SA(1, 0), cA + kstep, voffA); PG8_STAGE(PG8_SB(1, 1), cB + hstep + kstep, voffB);
        PG8_WAIT_V(6); PG8_BAR;
    } else {
        PG8_STAGE(PG8_SB(0, 0), cB, voffB); PG8_STAGE(PG8_SA(0, 0), cA, voffA); PG8_STAGE(PG8_SB(0, 1), cB + hstep, voffB); PG8_STAGE(PG8_SA(0, 1), cA + hstep, voffA);
        if (wr == 1) PG8_BAR;
        PG8_WAIT_V(4); PG8_BAR;
        PG8_STAGE(PG8_SB(1, 0), cB + kstep, voffB); PG8_STAGE(PG8_SA(1, 0), cA + kstep, voffA); PG8_STAGE(PG8_SB(1, 1), cB + hstep + kstep, voffB);
        PG8_WAIT_V(6); PG8_BAR;
    }
    for (;;) {
        const bool has_next = S.next(ui + 1, nxt);
        const char* nA = has_next ? (const char*)g.A + (size_t)nxt.pm * tstep : cA; const char* nB = has_next ? (const char*)g.Bt + (size_t)nxt.pn * tstep : cB;
#pragma unroll 1
        for (int t = 0; t < nt; t += 2) {
            const bool last = (t == nt - 2);
            const char* a1 = cA + (size_t)(t + 1) * kstep;
            const char* a2 = last ? nA : cA + (size_t)(t + 2) * kstep; const char* b2 = last ? nB : cB + (size_t)(t + 2) * kstep;
            const char* a3 = a2 + kstep; const char* b3 = b2 + kstep;
            if (last && has_next) S.a_ready(nxt);
            if constexpr (SP2) {
            PG8_LDB(B0, 0, 0); PG8_LDB(B1, 0, 1); PG8_SCHED; PG8_LDA(At, 0, 0); PG8_STAGE(PG8_SA(1, 1), a1 + hstep, voffA);
            PG8_WAIT_V(8); PG8_WAIT_L(0); PG8_BAR; PG8_MMA(0, 0, At, B0); PG8_MMA(0, 1, At, B1); PG8_BAR; PG8_SCHED;
            PG8_LDA(At, 0, 1); PG8_STAGE(PG8_SB(0, 0), b2, voffB); PG8_STAGE(PG8_SB(0, 1), b2 + hstep, voffB); PG8_STAGE(PG8_SA(0, 0), a2, voffA);
            PG8_WAIT_V(8); PG8_WAIT_L(0); PG8_BAR; PG8_MMA(1, 0, At, B0); PG8_MMA(1, 1, At, B1); PG8_BAR; PG8_SCHED;
            PG8_LDB(B0, 1, 0); PG8_LDB(B1, 1, 1); PG8_SCHED; PG8_LDA(At, 1, 0); PG8_STAGE(PG8_SA(0, 1), a2 + hstep, voffA);
            PG8_WAIT_V(8); PG8_WAIT_L(0); PG8_BAR; PG8_MMA(0, 0, At, B0); PG8_MMA(0, 1, At, B1); PG8_BAR; PG8_SCHED;
            PG8_LDA(At, 1, 1); PG8_STAGE(PG8_SB(1, 0), b3, voffB); PG8_STAGE(PG8_SB(1, 1), b3 + hstep, voffB); PG8_STAGE(PG8_SA(1, 0), a3, voffA);
            PG8_WAIT_V(8); PG8_WAIT_L(0); PG8_BAR; PG8_MMA(1, 0, At, B0); PG8_MMA(1, 1, At, B1); PG8_BAR; PG8_SCHED;
            } else {
            PG8_LDB(B0, 0, 0); PG8_SCHED; PG8_LDA(At, 0, 0); PG8_STAGE(PG8_SA(1, 1), a1 + hstep, voffA);
            PG8_WAIT_L(8); PG8_BAR; PG8_WAIT_L(0); PG8_MMA(0, 0, At, B0); PG8_BAR; PG8_SCHED;
            PG8_LDB(B1, 0, 1); PG8_STAGE(PG8_SB(0, 0), b2, voffB);
            PG8_BAR; PG8_WAIT_L(0); PG8_MMA(0, 1, At, B1); PG8_BAR;
            PG8_LDA(At, 0, 1); PG8_STAGE(PG8_SA(0, 0), a2, voffA);
            PG8_BAR; PG8_WAIT_L(0); PG8_MMA(1, 0, At, B0); PG8_BAR; PG8_SCHED;
            PG8_STAGE(PG8_SB(0, 1), b2 + hstep, voffB);
            PG8_WAIT_V(6); PG8_BAR; PG8_MMA(1, 1, At, B1); PG8_BAR;
            PG8_LDB(B0, 1, 0); PG8_SCHED; PG8_LDA(At, 1, 0); PG8_STAGE(PG8_SA(0, 1), a2 + hstep, voffA);
            PG8_WAIT_L(8); PG8_BAR; PG8_WAIT_L(0); PG8_MMA(0, 0, At, B0); PG8_BAR; PG8_SCHED;
            PG8_LDB(B1, 1, 1); PG8_STAGE(PG8_SB(1, 0), b3, voffB);
            PG8_BAR; PG8_WAIT_L(0); PG8_MMA(0, 1, At, B1); PG8_BAR;
            PG8_LDA(At, 1, 1); PG8_STAGE(PG8_SA(1, 0), a3, voffA);
            PG8_BAR; PG8_WAIT_L(0); PG8_MMA(1, 0, At, B0); PG8_BAR; PG8_SCHED;
            PG8_STAGE(PG8_SB(1, 1), b3 + hstep, voffB);
            PG8_WAIT_V(6); PG8_BAR; PG8_MMA(1, 1, At, B1); PG8_BAR;
            }
        }
        if constexpr (ALIGN_EPI) { if (wr == 0) PG8_BAR; }
        if constexpr (!Epi::AFTER_DRAIN) { E(acc, cur, wr, wc, fr, fq); S.done(cur); }
        if (!has_next) break;
#pragma unroll
        for (int a = 0; a < 2; ++a)
#pragma unroll
            for (int b = 0; b < 2; ++b)
#pragma unroll
                for (int m = 0; m < 4; ++m)
#pragma unroll
                    for (int n = 0; n < 2; ++n) acc[a][b][m][n] = (f32x4){0.f, 0.f, 0.f, 0.f};
        cur = nxt; cA = nA; cB = nB; ++ui;
        if constexpr (ALIGN_EPI) { if (wr == 1) PG8_BAR; }
    }
    PG8_WAIT_V(0);
    if constexpr (!ALIGN_EPI) { if (wr == 0) PG8_BAR; }
    PG8_BAR;
    if constexpr (Epi::AFTER_DRAIN) { E.fused(acc, cur, wr, wc, fr, fq, lds, wid, lane); S.done(cur); }
#undef PG8_SA
#undef PG8_SB
#undef PG8_STAGE
#undef PG8_LDA
#undef PG8_LDB
#undef PG8_MMA
#undef PG8_WAIT_V
#undef PG8_WAIT_L
#undef PG8_BAR
#undef PG8_SCHED
}
}

using pg8::bf16_t; using pg8::bf16x8; using pg8::f32x4; using pg8::u32x4; using pg8::f32x16; using pg8::cvt_pk_bf16; using pg8::fsigmoid; using pg8::fsilu; using pg8::RMS_EPS;
typedef float f32x2 __attribute__((ext_vector_type(2)));
typedef unsigned u32x2 __attribute__((ext_vector_type(2)));
constexpr int T = 16384, DM = 1024, FF = 2816, PW = 3856, NPAD = 4096, NS = 32, NCH = 256  , NCHB = 128  ;
constexpr int NTHR = 512, NWAVES = 8;
constexpr int LDS_BYTES = 147456;

constexpr size_t O_YP = 0, O_YS = 16777216, O_KAP = O_YS + 32768, O_VAP = O_KAP + 2097152, O_SBP = O_VAP + 2097152, O_SCP = O_SBP + 65536,
                 O_KAS = O_SCP + 16384, O_VAS = O_KAS + 32768, O_SBS = O_VAS + 32768, O_SCS = O_SBS + 2097152, O_END = O_SCS + 524288;
constexpr size_t al256(size_t x) { return (x + 255) & ~(size_t)255; }
constexpr size_t SZ_W1GU = (size_t)5632 * 1024 * 2, SZ_W1D = (size_t)1024 * 2816 * 2, SZ_WIN = (size_t)4096 * 1024 * 2, SZ_WOUT = (size_t)1024 * 1024 * 2, SZ_WPG = SZ_WOUT, SZ_WPP = (size_t)1024 * 256 * 2;
constexpr size_t WL_W1GU = 0, WL_W1D = WL_W1GU + SZ_W1GU, WL_WIN = WL_W1D + SZ_W1D, WL_WOUT = WL_WIN + SZ_WIN, WL_W2GU = WL_WOUT + SZ_WOUT, WL_W2D = WL_W2GU + SZ_W1GU,
                 WL_WPG = WL_W2D + SZ_W1D, WL_WPP = WL_WPG + SZ_WPG, WL_SIZE = WL_WPP + SZ_WPP;
constexpr size_t WS_W = 0;
constexpr size_t WS_HB0 = al256(WS_W + 2 * WL_SIZE), WS_HB1 = WS_HB0 + (size_t)T * DM * 2;
constexpr size_t WS_ACT = WS_HB1 + (size_t)T * DM * 2;
constexpr size_t WS_QB = WS_ACT + (size_t)T * FF * 2, WS_KB = WS_QB + (size_t)T * 512 * 2, WS_VB = WS_KB + (size_t)T * 512 * 2;
constexpr size_t WS_ZF = WS_VB + (size_t)T * 512 * 2;
constexpr size_t WS_OC = WS_ZF + (size_t)T * 2560 * 4, WS_LSE = WS_OC + (size_t)3 * T * 512 * 2;
constexpr size_t WS_MIX = WS_LSE + (size_t)3 * T * 8 * 4;
constexpr size_t WS_PB = WS_MIX + (size_t)T * DM * 2;
constexpr size_t WS_UB = WS_PB + (size_t)2 * T * 256 * 2, WS_UC = WS_UB + (size_t)NCH * 32768 * 4, WS_AB = WS_UC + (size_t)NCH * 8192 * 4, WS_AC = WS_AB + (size_t)NCH * 512 * 4;
constexpr size_t WS_SSQ0 = WS_AC + (size_t)NCH * 128 * 4, WS_SSQ1 = WS_SSQ0 + (size_t)T * 16 * 4;
constexpr size_t WS_PP = WS_SSQ1 + (size_t)T * 16 * 4;
constexpr size_t WS_LB = WS_PP + (size_t)T * DM * 4;
constexpr size_t WS_HSB0 = WS_LB + 4096, WS_HSB1 = WS_HSB0 + (size_t)NS * DM * 2, WS_ACTS = WS_HSB1 + (size_t)NS * DM * 2, WS_ZS = WS_ACTS + al256((size_t)NS * FF * 2),
                 WS_MIXS = WS_ZS + (size_t)NS * NPAD * 4, WS_PSB = WS_MIXS + (size_t)NS * DM * 2, WS_SSQS0 = WS_PSB + (size_t)2 * NS * 256 * 2, WS_SSQS1 = WS_SSQS0 + (size_t)NS * 32 * 4,
                 WS_BAR = al256(WS_SSQS1 + (size_t)NS * 32 * 4), WS_BAR_BYTES = 16384, WS_FCB = WS_BAR + WS_BAR_BYTES, WS_END = WS_FCB + (size_t)T * 128 * 4;

struct Args { const float* in[28]; float* out; unsigned char* ws; };

#define LWAIT() asm volatile("s_waitcnt lgkmcnt(0)" ::: "memory")
__device__ __forceinline__ float wave_sum(float v) {
#pragma unroll
    for (int o = 1; o < 64; o <<= 1) v += __shfl_xor(v, o);
    return v;
}
__device__ __forceinline__ unsigned pk2(float lo, float hi) { return cvt_pk_bf16(lo, hi); }

__device__ __forceinline__ int map_row(int kind, int n) {
    if (kind == 1) return 256 * (n >> 7) + (n & 127);
    if (kind == 2) return 256 * (n >> 7) + (n & 127) + 128;
    if (kind == 3) return n < 3584 ? n : (n < 3600 ? 3840 + (n - 3584) : 3584 + (n - 3600));
    return n;
}
__device__ __forceinline__ void tr_item(const float* W, int K, int N, const float* gain, bf16_t* WT, int kind, float* scr, int item, int lane) {
    const int nblk = (N + 31) / 32, kb = item / nblk, nb = item % nblk, k0 = 64 * kb, n0 = 32 * nb;
    const int c = lane & 7;
    float wv[32];
    {
        const int n = n0 + (lane & 31); const bool ok = n < N;
        const float* wp = W + (size_t)(k0 + (lane >> 5)) * N + (ok ? n : 0);
#pragma unroll
        for (int i = 0; i < 32; ++i) wv[i] = wp[(size_t)(2 * i) * N];
#pragma unroll
        for (int i = 0; i < 32; ++i) scr[(2 * i + (lane >> 5)) * 33 + (lane & 31)] = ok ? wv[i] : 0.f;
    }
    f32x4 g0 = (f32x4){1.f, 1.f, 1.f, 1.f}, g1 = g0;
    if (gain) { g0 = *(const f32x4*)(gain + k0 + 8 * c); g1 = *(const f32x4*)(gain + k0 + 8 * c + 4); }
    LWAIT();
#pragma unroll
    for (int j = 0; j < 4; ++j) {
        const int nl = (lane >> 3) + 8 * j, n = n0 + nl;
        const float* s = scr + (8 * c) * 33 + nl;
        u32x4 o; o.x = pk2(s[0 * 33] * g0[0], s[1 * 33] * g0[1]); o.y = pk2(s[2 * 33] * g0[2], s[3 * 33] * g0[3]); o.z = pk2(s[4 * 33] * g1[0], s[5 * 33] * g1[1]); o.w = pk2(s[6 * 33] * g1[2], s[7 * 33] * g1[3]);
        if (n < N) *(u32x4*)(WT + (size_t)map_row(kind, n) * K + k0 + 8 * c) = o;
    }
    LWAIT();
}

__device__ __forceinline__ void sgemm_tile(const bf16_t* A, const bf16_t* Bt, int K, int n0, float* part, int wave, int lane) {
    const int c32 = lane & 31, hi = lane >> 5, nch = K >> 6;
    f32x16 acc;
#pragma unroll
    for (int i = 0; i < 16; ++i) acc[i] = 0.f;
    for (int ch0 = wave; ch0 < nch; ch0 += 3 * NWAVES) {
        bf16x8 a[3][4], b[3][4];
#pragma unroll
        for (int c = 0; c < 3; ++c) { const int ch = ch0 + c * NWAVES;
            if (ch < nch) { const bf16_t* ap = A + (size_t)c32 * K + ch * 64 + hi * 32; const bf16_t* bp = Bt + (size_t)(n0 + c32) * K + ch * 64 + hi * 32;
#pragma unroll
                for (int j = 0; j < 4; ++j) { a[c][j] = *(const bf16x8*)(ap + 8 * j); b[c][j] = *(const bf16x8*)(bp + 8 * j); } } }
#pragma unroll
        for (int c = 0; c < 3; ++c) { const int ch = ch0 + c * NWAVES;
            if (ch < nch) {
#pragma unroll
                for (int j = 0; j < 4; ++j) acc = __builtin_amdgcn_mfma_f32_32x32x16_bf16(a[c][j], b[c][j], acc, 0, 0, 0); } }
    }
#pragma unroll
    for (int rr = 0; rr < 16; ++rr) { const int row = (rr & 3) + 8 * (rr >> 2) + 4 * hi; part[(wave * 32 + row) * 33 + c32] = acc[rr]; }
}
__device__ __forceinline__ float part_sum(const float* part, int row, int col) {
    float s = 0.f;
#pragma unroll
    for (int w = 0; w < NWAVES; ++w) s += part[(w * 32 + row) * 33 + col];
    return s;
}
__device__ __forceinline__ float row_rinv32(const float* ssqs, int row) {
    const f32x4* p = (const f32x4*)(ssqs + row * 32); float s = 0.f;
#pragma unroll
    for (int i = 0; i < 8; ++i) { const f32x4 a = p[i]; s += (a[0] + a[1]) + (a[2] + a[3]); }
    return rsqrtf(s * (1.0f / 1024.0f) + RMS_EPS);
}
constexpr int PART_FLOATS = 8 * 32 * 33;

#define ATT_LOAD_QK(UNIT) do { const int cfg_ = (UNIT) >> 12, rem_ = (UNIT) & 4095, h_ = rem_ >> 9, blk_ = rem_ & 511, dsh_ = cfg_ * 2, r_ = blk_ >> (9 - dsh_), i0_ = (blk_ & ((512 >> dsh_) - 1)) * 32; \
        const int tq_ = ((i0_ + c32) << dsh_) + r_; \
        _Pragma("unroll") for (int s = 0; s < 4; ++s) qf[s] = *(const bf16x8*)(Qb + (size_t)tq_ * 512 + h_ * 64 + 16 * s + 8 * hi); \
        _Pragma("unroll") for (int kt = 0; kt < 2; ++kt) { int ik = i0_ - 128 + 32 * kt + c32; ik = ik < 0 ? 0 : ik; \
            const bf16_t* kp = Kb + (size_t)((ik << dsh_) + r_) * 512 + h_ * 64 + 8 * hi; \
            _Pragma("unroll") for (int s = 0; s < 4; ++s) kf[kt][s] = *(const bf16x8*)(kp + 16 * s); } } while (0)
__device__ __forceinline__ void attn_units(unsigned char* wsb, int unit0, int nu, unsigned char* vt, int lane) {
    const bf16_t* Qb = (const bf16_t*)(wsb + WS_QB); const bf16_t* Kb = (const bf16_t*)(wsb + WS_KB); const bf16_t* Vb = (const bf16_t*)(wsb + WS_VB);
    bf16_t* Oc = (bf16_t*)(wsb + WS_OC); float* LSE = (float*)(wsb + WS_LSE);
    const int c32 = lane & 31, hi = lane >> 5;
    bf16x8 qf[4], kf[5][4];
    if (nu > 0) ATT_LOAD_QK(unit0);
    for (int ui = 0; ui < nu; ++ui) {
        const int unit = unit0 + ui;
        const int cfg = unit >> 12, rem = unit & 4095, h = rem >> 9, blk = rem & 511;
        const int dsh = cfg * 2, dil = 1 << dsh;
        const int r = blk >> (9 - dsh), ib = blk & ((512 >> dsh) - 1), i0 = ib * 32;
        const float sl2 = exp2f(-(float)(h + 1)) * (float)dil * 1.4426950408889634f;
        const int tq = ((i0 + c32) << dsh) + r;
        float brr[16];
#pragma unroll
        for (int rr = 0; rr < 16; ++rr) brr[rr] = sl2 * (float)((rr & 3) + 8 * (rr >> 2) + 4 * hi);
#pragma unroll
        for (int kt = 2; kt < 5; ++kt) { int ik = i0 - 128 + 32 * kt + c32; ik = ik < 0 ? 0 : ik;
            const bf16_t* kp = Kb + (size_t)((ik << dsh) + r) * 512 + h * 64 + 8 * hi;
#pragma unroll
            for (int s = 0; s < 4; ++s) kf[kt][s] = *(const bf16x8*)(kp + 16 * s); }
        f32x16 st[5];
#pragma unroll
        for (int kt = 0; kt < 5; ++kt) {
            const float base = -sl2 * (float)(128 + c32 - 32 * kt);
            f32x16 a;
#pragma unroll
            for (int i = 0; i < 16; ++i) a[i] = base + brr[i];
#pragma unroll
            for (int s = 0; s < 4; ++s) a = __builtin_amdgcn_mfma_f32_32x32x16_bf16(kf[kt][s], qf[s], a, 0, 0, 0);
            st[kt] = a;
        }
        u32x4 vreg[3][4];
#pragma unroll
        for (int kt = 0; kt < 3; ++kt)
#pragma unroll
            for (int cc = 0; cc < 4; ++cc) {
                const int chunk = lane + 64 * cc, key = chunk >> 3, part = chunk & 7;
                int ik = i0 - 128 + 32 * kt + key; ik = ik < 0 ? 0 : ik;
                vreg[kt][cc] = *(const u32x4*)(Vb + (size_t)((ik << dsh) + r) * 512 + h * 64 + part * 8);
            }
#pragma unroll
        for (int rr = 0; rr < 16; ++rr) {
            const int kk = (rr & 3) + 8 * (rr >> 2) + 4 * hi;
            st[0][rr] = (kk >= c32) ? st[0][rr] : -1e30f;
            st[4][rr] = (kk <= c32) ? st[4][rr] : -1e30f;
        }
        if (i0 < 128) {
#pragma unroll
            for (int kt = 0; kt < 4; ++kt)
#pragma unroll
                for (int rr = 0; rr < 16; ++rr) { const int kk = (rr & 3) + 8 * (rr >> 2) + 4 * hi; st[kt][rr] = (i0 - 128 + 32 * kt + kk >= 0) ? st[kt][rr] : -1e30f; }
        }
        float mx = -1e30f;
#pragma unroll
        for (int kt = 0; kt < 5; ++kt)
#pragma unroll
            for (int rr = 0; rr < 16; ++rr) mx = fmaxf(mx, st[kt][rr]);
        mx = fmaxf(mx, __shfl_xor(mx, 32));
        float den = 0.f;
        bf16x8 pf[5][2];
#pragma unroll
        for (int kt = 0; kt < 5; ++kt)
#pragma unroll
            for (int s2 = 0; s2 < 2; ++s2) {
                float p[8];
#pragma unroll
                for (int j = 0; j < 8; ++j) { p[j] = __builtin_amdgcn_exp2f(st[kt][8 * s2 + j] - mx); den += p[j]; }
                u32x4 w; w.x = cvt_pk_bf16(p[0], p[1]); w.y = cvt_pk_bf16(p[2], p[3]); w.z = cvt_pk_bf16(p[4], p[5]); w.w = cvt_pk_bf16(p[6], p[7]);
                pf[kt][s2] = __builtin_bit_cast(bf16x8, w);
            }
        den += __shfl_xor(den, 32);
        if (ui + 1 < nu) ATT_LOAD_QK(unit + 1);
        f32x16 o0, o1;
#pragma unroll
        for (int i = 0; i < 16; ++i) { o0[i] = 0.f; o1[i] = 0.f; }
#pragma unroll
        for (int kt = 0; kt < 5; ++kt) {
#pragma unroll
            for (int cc = 0; cc < 4; ++cc) {
                const int chunk = lane + 64 * cc, key = chunk >> 3, part = chunk & 7;
                *(u32x4*)(vt + key * 144 + part * 16) = vreg[kt % 3][cc];
            }
            if (kt < 2) {
#pragma unroll
                for (int cc = 0; cc < 4; ++cc) {
                    const int chunk = lane + 64 * cc, key = chunk >> 3, part = chunk & 7;
                    int ik = i0 - 128 + 32 * (kt + 3) + key; ik = ik < 0 ? 0 : ik;
                    vreg[kt][cc] = *(const u32x4*)(Vb + (size_t)((ik << dsh) + r) * 512 + h * 64 + part * 8);
                }
            }
            LWAIT();
#pragma unroll
            for (int s2 = 0; s2 < 2; ++s2) {
#pragma unroll
                for (int dh = 0; dh < 2; ++dh) {
                    typedef short v4i16_t __attribute__((ext_vector_type(4)));
                    const int trow = (lane >> 2) & 3, tcol = 16 * ((lane >> 4) & 1) + 4 * (lane & 3) + 32 * dh;
                    const v4i16_t lo4 = __builtin_amdgcn_ds_read_tr16_b64_v4i16((__attribute__((address_space(3))) v4i16_t*)(vt + (16 * s2 + 4 * hi + trow) * 144 + tcol * 2));
                    const v4i16_t hi4 = __builtin_amdgcn_ds_read_tr16_b64_v4i16((__attribute__((address_space(3))) v4i16_t*)(vt + (16 * s2 + 8 + 4 * hi + trow) * 144 + tcol * 2));
                    bf16x8 vf; vf[0] = lo4[0]; vf[1] = lo4[1]; vf[2] = lo4[2]; vf[3] = lo4[3]; vf[4] = hi4[0]; vf[5] = hi4[1]; vf[6] = hi4[2]; vf[7] = hi4[3];
                    if (dh == 0) o0 = __builtin_amdgcn_mfma_f32_32x32x16_bf16(vf, pf[kt][s2], o0, 0, 0, 0);
                    else         o1 = __builtin_amdgcn_mfma_f32_32x32x16_bf16(vf, pf[kt][s2], o1, 0, 0, 0);
                }
            }
            LWAIT();
        }
        const float inv = 1.0f / den;
        bf16_t* op = Oc + ((size_t)cfg * T + tq) * 512 + h * 64 + 4 * hi;
#pragma unroll
        for (int g = 0; g < 4; ++g) {
            u32x2 w0, w1;
            w0.x = cvt_pk_bf16(o0[4 * g] * inv, o0[4 * g + 1] * inv); w0.y = cvt_pk_bf16(o0[4 * g + 2] * inv, o0[4 * g + 3] * inv);
            w1.x = cvt_pk_bf16(o1[4 * g] * inv, o1[4 * g + 1] * inv); w1.y = cvt_pk_bf16(o1[4 * g + 2] * inv, o1[4 * g + 3] * inv);
            *(u32x2*)(op + 8 * g) = w0; *(u32x2*)(op + 32 + 8 * g) = w1;
        }
        if (hi == 0) LSE[((size_t)cfg * T + tq) * 8 + h] = (mx + __builtin_amdgcn_logf(den)) * 0.6931471805599453f;
    }
}

#define LO2(v) (__builtin_shufflevector((v), (v), 0, 1))
#define HI2(v) (__builtin_shufflevector((v), (v), 2, 3))
__device__ __forceinline__ f32x4 fgate4(f32x4 z, f32x4 lbv) { f32x4 o;
#pragma unroll
    for (int j = 0; j < 4; ++j) o[j] = lbv[j] + (1.0f - lbv[j]) * fsigmoid(z[j]);
    return o; }
__device__ __forceinline__ f32x4 silu4(f32x4 z) { f32x4 o;
#pragma unroll
    for (int j = 0; j < 4; ++j) o[j] = fsilu(z[j]);
    return o; }
__device__ __forceinline__ void b_local(const float* ZF, const float* lb, float* UB, float* AB, int n, int h, unsigned char* smem, int tid, int wave, int lane) {
    float* fL = (float*)smem; float* vL = fL + 128 * 128;
    const int t0 = 128 * n;
    {
        f32x4 rf[8], rv[4];
        const f32x4 lbv = *(const f32x4*)(lb + h * 128 + 4 * (tid & 31));
#pragma unroll
        for (int i = 0; i < 8; ++i) { const int idx = tid + NTHR * i, t = idx >> 5, k4 = idx & 31; rf[i] = *(const f32x4*)(ZF + (size_t)(t0 + t) * 2560 + 512 + h * 128 + 4 * k4); }
#pragma unroll
        for (int i = 0; i < 4; ++i) { const int idx = tid + NTHR * i, t = idx >> 4, v4 = idx & 15; rv[i] = *(const f32x4*)(ZF + (size_t)(t0 + t) * 2560 + 1024 + h * 64 + 4 * v4); }
#pragma unroll
        for (int i = 0; i < 8; ++i) { const int idx = tid + NTHR * i, t = idx >> 5, k4 = idx & 31; *(f32x4*)(fL + t * 128 + 4 * k4) = fgate4(rf[i], lbv); }
#pragma unroll
        for (int i = 0; i < 4; ++i) { const int idx = tid + NTHR * i, t = idx >> 4, v4 = idx & 15; *(f32x4*)(vL + t * 64 + 4 * v4) = rv[i]; }
    }
    __syncthreads();
    f32x2 S[8];
#pragma unroll
    for (int k = 0; k < 8; ++k) S[k] = (f32x2){0.f, 0.f};
    {
        f32x4 fc[4]; float vc = vL[lane];
#pragma unroll
        for (int q4 = 0; q4 < 4; ++q4) fc[q4] = *(const f32x4*)(fL + 16 * wave + 4 * q4);
#pragma unroll 2
        for (int t = 0; t < 128; ++t) {
            const int tn = (t + 1) & 127;
            f32x4 fn[4]; const float vn = vL[tn * 64 + lane];
#pragma unroll
            for (int q4 = 0; q4 < 4; ++q4) fn[q4] = *(const f32x4*)(fL + tn * 128 + 16 * wave + 4 * q4);
            const f32x2 vc2 = (f32x2){vc, vc};
#pragma unroll
            for (int q4 = 0; q4 < 4; ++q4) { S[2 * q4] = LO2(fc[q4]) * (S[2 * q4] - vc2) + vc2; S[2 * q4 + 1] = HI2(fc[q4]) * (S[2 * q4 + 1] - vc2) + vc2; }
#pragma unroll
            for (int q4 = 0; q4 < 4; ++q4) fc[q4] = fn[q4];
            vc = vn;
        }
    }
    float* up = UB + ((size_t)(n * 4 + h) * 128 + 16 * wave) * 64 + lane;
#pragma unroll
    for (int k = 0; k < 8; ++k) { up[(2 * k) * 64] = S[k][0]; up[(2 * k + 1) * 64] = S[k][1]; }
    { float ap = 1.f; const int kq = lane & 15, pt = lane >> 4;
#pragma unroll
      for (int t = 0; t < 32; ++t) ap *= fL[(32 * pt + t) * 128 + 16 * wave + kq];
      ap *= __shfl_xor(ap, 16); ap *= __shfl_xor(ap, 32);
      if (lane < 16) AB[(size_t)(n * 4 + h) * 128 + 16 * wave + lane] = ap; }
    __syncthreads();
}
__device__ __forceinline__ void b_output(const float* ZF, const float* lb, const float* S0B, const float* bnorm, bf16_t* mixed, int n, int h, unsigned char* smem, int tid, int wave, int lane) {
    float* fL = (float*)smem; float* qL = fL + 32 * 128; float* vL = qL + 32 * 128; float* oP = vL + 32 * 64;
    f32x2 S[8];
    { const float* sp = S0B + ((size_t)(n * 4 + h) * 128 + 16 * wave) * 64 + lane;
#pragma unroll
      for (int k = 0; k < 8; ++k) { S[k][0] = sp[(2 * k) * 64]; S[k][1] = sp[(2 * k + 1) * 64]; } }
    const int lt = tid >> 5, lk4 = tid & 31;
    const int rt = tid >> 4, rv4 = tid & 15;
    const f32x4 lbv = *(const f32x4*)(lb + h * 128 + 4 * lk4);
    const f32x4 bn = *(const f32x4*)(bnorm + h * 64 + 4 * rv4);
    f32x4 rf[2], rq[2], rv;
    { const int t0 = 128 * n;
#pragma unroll
      for (int i = 0; i < 2; ++i) { const float* zr = ZF + (size_t)(t0 + lt + 16 * i) * 2560 + h * 128 + 4 * lk4; rf[i] = *(const f32x4*)(zr + 512); rq[i] = *(const f32x4*)zr; }
      rv = *(const f32x4*)(ZF + (size_t)(t0 + rt) * 2560 + 1024 + h * 64 + 4 * rv4); }
    for (int sc = 0; sc < 4; ++sc) {
        const int t0 = 128 * n + 32 * sc;
#pragma unroll
        for (int i = 0; i < 2; ++i) { *(f32x4*)(fL + (lt + 16 * i) * 128 + 4 * lk4) = fgate4(rf[i], lbv); *(f32x4*)(qL + (lt + 16 * i) * 128 + 4 * lk4) = silu4(rq[i]); }
        *(f32x4*)(vL + rt * 64 + 4 * rv4) = rv;
        const f32x4 g = *(const f32x4*)(ZF + (size_t)(t0 + rt) * 2560 + 1280 + h * 64 + 4 * rv4);
        __syncthreads();
        if (sc < 3) {
#pragma unroll
            for (int i = 0; i < 2; ++i) { const float* zr = ZF + (size_t)(t0 + 32 + lt + 16 * i) * 2560 + h * 128 + 4 * lk4; rf[i] = *(const f32x4*)(zr + 512); rq[i] = *(const f32x4*)zr; }
            rv = *(const f32x4*)(ZF + (size_t)(t0 + 32 + rt) * 2560 + 1024 + h * 64 + 4 * rv4);
        }
        {
            f32x4 fc[4], qc[4]; float vc = vL[lane];
#pragma unroll
            for (int q4 = 0; q4 < 4; ++q4) { fc[q4] = *(const f32x4*)(fL + 16 * wave + 4 * q4); qc[q4] = *(const f32x4*)(qL + 16 * wave + 4 * q4); }
#pragma unroll 2
            for (int t = 0; t < 32; ++t) {
                const int tn = (t + 1) & 31;
                f32x4 fn[4], qn[4]; const float vn = vL[tn * 64 + lane];
#pragma unroll
                for (int q4 = 0; q4 < 4; ++q4) { fn[q4] = *(const f32x4*)(fL + tn * 128 + 16 * wave + 4 * q4); qn[q4] = *(const f32x4*)(qL + tn * 128 + 16 * wave + 4 * q4); }
                const f32x2 vc2 = (f32x2){vc, vc}; f32x2 oa = (f32x2){0.f, 0.f}, ob = oa;
#pragma unroll
                for (int q4 = 0; q4 < 4; ++q4) {
                    const f32x2 s0 = LO2(fc[q4]) * (S[2 * q4] - vc2) + vc2, s1 = HI2(fc[q4]) * (S[2 * q4 + 1] - vc2) + vc2;
                    S[2 * q4] = s0; S[2 * q4 + 1] = s1; oa += LO2(qc[q4]) * s0; ob += HI2(qc[q4]) * s1;
                }
                oa += ob;
                oP[(wave * 32 + t) * 64 + lane] = oa[0] + oa[1];
#pragma unroll
                for (int q4 = 0; q4 < 4; ++q4) { fc[q4] = fn[q4]; qc[q4] = qn[q4]; }
                vc = vn;
            }
        }
        __syncthreads();
        { f32x4 o = (f32x4){0.f, 0.f, 0.f, 0.f};
#pragma unroll
          for (int w = 0; w < 8; ++w) o += *(const f32x4*)(oP + (w * 32 + rt) * 64 + 4 * rv4);
          float ss = (o[0] * o[0] + o[1] * o[1]) + (o[2] * o[2] + o[3] * o[3]);
#pragma unroll
          for (int d = 1; d < 16; d <<= 1) ss += __shfl_xor(ss, d);
          const float rinv = rsqrtf(ss * (1.0f / 64.0f) + RMS_EPS);
          u32x2 w2; w2.x = cvt_pk_bf16(o[0] * rinv * bn[0] * fsigmoid(g[0]), o[1] * rinv * bn[1] * fsigmoid(g[1])); w2.y = cvt_pk_bf16(o[2] * rinv * bn[2] * fsigmoid(g[2]), o[3] * rinv * bn[3] * fsigmoid(g[3]));
          *(u32x2*)(mixed + (size_t)(t0 + rt) * 1024 + 512 + h * 64 + 4 * rv4) = w2; }
    }
    __syncthreads();
}

__device__ __forceinline__ float logsig16_exp(float x) {
    const float ls = fminf(x, 0.f) - __logf(1.0f + __expf(-fabsf(x)));
    return __expf(ls * 0.0625f);
}
template <bool OUT>
__device__ __forceinline__ void c_task(const float* ZF, float* FCB, const float* cwg, const float* cbias, float* UC, float* AC, const float* cnorm, bf16_t* mixed,
                                       int n, int h, float* wl  , int lane) {
    float* fcL = wl; float* kcL = wl + 512; float* qcL = wl + 1024; float* vL = wl + 1536; float* gL = wl + 2560;
    const int k = lane & 31, th = lane >> 5;
    float cw[16];
#pragma unroll
    for (int r = 0; r < 16; ++r) cw[r] = OUT ? 0.f : cwg[r * 128 + h * 32 + k];
    const float cb = OUT ? 0.f : cbias[h * 32 + k];
    const float cn = OUT ? cnorm[h * 64 + lane] : 0.f;
    f32x2 S[16];
    float* ucp = UC + ((size_t)(n * 4 + h) * 32) * 64 + lane;
#pragma unroll
    for (int kk = 0; kk < 16; ++kk) { S[kk][0] = OUT ? ucp[(2 * kk) * 64] : 0.f; S[kk][1] = OUT ? ucp[(2 * kk + 1) * 64] : 0.f; }
    float ap = 1.f;
#pragma unroll 1
    for (int sc = 0; sc < 4; ++sc) {
        const int t0 = 64 * n + 16 * sc;
        {
            float rk[8], rq[8], rfc[8], rvv[16], rgg[16]; f32x4 rclr = (f32x4){0.f, 0.f, 0.f, 0.f};
#pragma unroll
            for (int i = 0; i < 8; ++i) { const int t = 2 * i + th; const float* zr = ZF + (size_t)(t0 + t) * 2560;
                rk[i] = zr[1664 + h * 32 + k]; rq[i] = OUT ? zr[1536 + h * 32 + k] : 0.f; rfc[i] = OUT ? FCB[(size_t)(t0 + t) * 128 + h * 32 + k] : 0.f; }
#pragma unroll
            for (int t = 0; t < 16; ++t) { rvv[t] = ZF[(size_t)(t0 + t) * 2560 + 1792 + h * 64 + lane]; rgg[t] = OUT ? ZF[(size_t)(t0 + t) * 2560 + 2048 + h * 64 + lane] : 0.f; }
            if (!OUT) rclr = *(const f32x4*)(ZF + (size_t)(t0 + (lane >> 2)) * 2560 + 2304 + 4 * (lane & 3));
#pragma unroll
            for (int i = 0; i < 8; ++i) { const int t = 2 * i + th; kcL[t * 32 + k] = rk[i]; if (OUT) { qcL[t * 32 + k] = rq[i] * 0.17677669529663687f; fcL[t * 32 + k] = rfc[i]; } }
#pragma unroll
            for (int t = 0; t < 16; ++t) { vL[t * 64 + lane] = rvv[t]; if (OUT) gL[t * 64 + lane] = fsilu(rgg[t]); }
            if (!OUT) {
                *(f32x4*)(gL + 4 * lane) = rclr;
                LWAIT();
#pragma unroll 2
                for (int i = 0; i < 8; ++i) { const int t = 2 * i + th;
                    float x = cb;
#pragma unroll
                    for (int r4 = 0; r4 < 4; ++r4) { const f32x4 c4 = *(const f32x4*)(gL + t * 16 + 4 * r4); x += c4[0] * cw[4 * r4] + c4[1] * cw[4 * r4 + 1] + c4[2] * cw[4 * r4 + 2] + c4[3] * cw[4 * r4 + 3]; }
                    const float fv = logsig16_exp(x);
                    fcL[t * 32 + k] = fv; FCB[(size_t)(t0 + t) * 128 + h * 32 + k] = fv; }
            }
        }
        LWAIT();
        if (!OUT) {
#pragma unroll 4
            for (int t = 0; t < 16; ++t) ap *= fcL[t * 32 + k];
        }
        {
            f32x4 fcu[4], kcu[4], qcu[4];
#pragma unroll
            for (int j = 0; j < 4; ++j) { fcu[j] = *(const f32x4*)(fcL + 4 * j); kcu[j] = *(const f32x4*)(kcL + 4 * j); qcu[j] = OUT ? *(const f32x4*)(qcL + 4 * j) : (f32x4){0.f, 0.f, 0.f, 0.f}; }
            float vv = vL[lane]; f32x2 o2 = (f32x2){0.f, 0.f};
#pragma unroll 2
            for (int u = 0; u < 32; ++u) {
                const int half = u & 1, t = u >> 1, un = (u + 1) & 31, tn = un >> 1, hn = un & 1;
                f32x4 fnu[4], knu[4], qnu[4];
#pragma unroll
                for (int j = 0; j < 4; ++j) { fnu[j] = *(const f32x4*)(fcL + tn * 32 + 16 * hn + 4 * j); knu[j] = *(const f32x4*)(kcL + tn * 32 + 16 * hn + 4 * j); qnu[j] = OUT ? *(const f32x4*)(qcL + tn * 32 + 16 * hn + 4 * j) : (f32x4){0.f, 0.f, 0.f, 0.f}; }
                const float vnx = vL[tn * 64 + lane];
                const f32x2 vv2 = (f32x2){vv, vv};
#pragma unroll
                for (int j = 0; j < 4; ++j) {
                    if (half == 0) { const f32x2 s0 = LO2(fcu[j]) * S[2 * j] + LO2(kcu[j]) * vv2, s1 = HI2(fcu[j]) * S[2 * j + 1] + HI2(kcu[j]) * vv2; S[2 * j] = s0; S[2 * j + 1] = s1; if (OUT) { o2 += LO2(qcu[j]) * s0; o2 += HI2(qcu[j]) * s1; } }
                    else           { const f32x2 s0 = LO2(fcu[j]) * S[8 + 2 * j] + LO2(kcu[j]) * vv2, s1 = HI2(fcu[j]) * S[8 + 2 * j + 1] + HI2(kcu[j]) * vv2; S[8 + 2 * j] = s0; S[8 + 2 * j + 1] = s1; if (OUT) { o2 += LO2(qcu[j]) * s0; o2 += HI2(qcu[j]) * s1; } }
                }
                if (half == 1) { if (OUT) vL[t * 64 + lane] = o2[0] + o2[1]; o2 = (f32x2){0.f, 0.f}; vv = vnx; }
#pragma unroll
                for (int j = 0; j < 4; ++j) { fcu[j] = fnu[j]; kcu[j] = knu[j]; qcu[j] = qnu[j]; }
            }
        }
        LWAIT();
        if (OUT) {
            { const int t = lane >> 2, part = lane & 3; float ss = 0.f;
#pragma unroll
              for (int i = 0; i < 4; ++i) { const f32x4 x = *(const f32x4*)(vL + t * 64 + part * 16 + 4 * i); ss += (x[0] * x[0] + x[1] * x[1]) + (x[2] * x[2] + x[3] * x[3]); }
              ss += __shfl_xor(ss, 1); ss += __shfl_xor(ss, 2);
              if (part == 0) fcL[t] = rsqrtf(ss * (1.0f / 64.0f) + RMS_EPS); }
            LWAIT();
#pragma unroll 4
            for (int t = 0; t < 16; ++t) {
                const float y = vL[t * 64 + lane] * fcL[t] * cn * gL[t * 64 + lane];
                mixed[(size_t)(t0 + t) * 1024 + 768 + h * 64 + lane] = (bf16_t)(cvt_pk_bf16(y, 0.f) & 0xffffu);
            }
            LWAIT();
        }
    }
    if (!OUT) {
#pragma unroll
        for (int kk = 0; kk < 16; ++kk) { ucp[(2 * kk) * 64] = S[kk][0]; ucp[(2 * kk + 1) * 64] = S[kk][1]; }
        if (lane < 32) AC[(size_t)(n * 4 + h) * 32 + k] = ap;
    }
}

__device__ __forceinline__ void s_attn(const float* zs, const float* ck, const float* cv  , bf16_t* mixs, float* kas, float* vas,
                                       int b, int h, unsigned char* smem, int tid, int wave, int lane) {
    float* sc = (float*)smem;
    float* pr = sc + 400;
    float* po = pr + 400;
    const float* zr = zs + (size_t)b * NPAD;
    const float slope = exp2f(-(float)(h + 1));
    if (tid < 387) {
        const int cfg = tid / 129, j = tid % 129, dil = 1 << (2 * cfg);
        const float* kr = (j == 0) ? (zr + 512 + h * 64) : (ck + ((size_t)b * 2048 + (2048 - j * dil)) * 512 + h * 64);
        float d = 0.f;
#pragma unroll
        for (int i = 0; i < 16; ++i) { const f32x4 kv = *(const f32x4*)(kr + 4 * i), qv = *(const f32x4*)(zr + h * 64 + 4 * i); d += kv[0] * qv[0] + kv[1] * qv[1] + kv[2] * qv[2] + kv[3] * qv[3]; }
        sc[tid] = d * 0.125f - slope * (float)(j * dil);
        ((int*)(po + 512))[tid] = (j == 0) ? -1 : (2048 - j * dil);
    }
    __syncthreads();
    float mx = -1e30f;
    for (int i = lane; i < 387; i += 64) mx = fmaxf(mx, sc[i]);
#pragma unroll
    for (int o = 1; o < 64; o <<= 1) mx = fmaxf(mx, __shfl_xor(mx, o));
    float den = 0.f;
    for (int i = lane; i < 387; i += 64) den += __expf(sc[i] - mx);
    den = wave_sum(den);
    if (tid < 387) pr[tid] = __expf(sc[tid] - mx) / den;
    __syncthreads();
    {
        const int d4 = tid & 15, part = tid >> 4;
        const int* ro = (const int*)(po + 512);
        const float* vnew = zr + 1024 + h * 64; const float* vbase = cv + (size_t)b * 2048 * 512 + h * 64;
        f32x4 vrow[13]; float pw[13];
#pragma unroll
        for (int j = 0; j < 13; ++j) { const int i = part + 32 * j; const bool ok = i < 387; const int rr = ok ? ro[i] : -1;
            const float* vr = (rr < 0) ? vnew : (vbase + (size_t)rr * 512);
            vrow[j] = *(const f32x4*)(vr + 4 * d4); pw[j] = ok ? pr[i] : 0.f; }
        f32x4 a = (f32x4){0.f, 0.f, 0.f, 0.f};
#pragma unroll
        for (int j = 0; j < 13; ++j) a += vrow[j] * pw[j];
        float* pp2 = po + 1024;
        *(f32x4*)(pp2 + part * 64 + 4 * d4) = a;
    }
    __syncthreads();
    if (tid < 64) { float o = 0.f;
#pragma unroll
        for (int p = 0; p < 32; ++p) o += po[1024 + p * 64 + tid];
        po[tid] = o; }
    __syncthreads();
    if (tid < 64) {
        const float o = po[tid];
        mixs[(size_t)b * 1024 + h * 64 + tid] = (bf16_t)(cvt_pk_bf16(o, 0.f) & 0xffffu);
        kas[(size_t)b * 512 + h * 64 + tid] = zr[512 + h * 64 + tid];
        vas[(size_t)b * 512 + h * 64 + tid] = zr[1024 + h * 64 + tid];
    }
    __syncthreads();
}
__device__ __forceinline__ void s_b(const float* zs, const float* sb0  , float* sbo  , const float* lb, const float* bnorm, bf16_t* mixs,
                                    int b, int h, unsigned char* smem, int tid, int wave, int lane) {
    float* po = (float*)smem;
    const float* zr = zs + (size_t)b * NPAD;
    const float vv = zr[2560 + h * 64 + lane];
    float op = 0.f;
    {
        float s0v[16], zf[16], zq[16], lbk[16];
#pragma unroll
        for (int kk = 0; kk < 16; ++kk) { const int k = 16 * wave + kk; s0v[kk] = sb0[(((size_t)b * 4 + h) * 128 + k) * 64 + lane]; zf[kk] = zr[2048 + h * 128 + k]; zq[kk] = zr[1536 + h * 128 + k]; lbk[kk] = lb[h * 128 + k]; }
#pragma unroll
        for (int kk = 0; kk < 16; ++kk) { const int k = 16 * wave + kk;
            const float f = lbk[kk] + (1.0f - lbk[kk]) * (1.0f / (1.0f + __expf(-zf[kk])));
            const float s1 = f * s0v[kk] + (1.0f - f) * vv;
            sbo[(((size_t)b * 4 + h) * 128 + k) * 64 + lane] = s1;
            op += fsilu(zq[kk]) * s1; }
    }
    po[wave * 64 + lane] = op;
    __syncthreads();
    if (tid < 64) {
        float o = 0.f;
#pragma unroll
        for (int w = 0; w < 8; ++w) o += po[w * 64 + tid];
        const float ss = wave_sum(o * o);
        const float y = o * rsqrtf(ss * (1.0f / 64.0f) + RMS_EPS) * bnorm[h * 64 + tid] * fsigmoid(zr[2816 + h * 64 + tid]);
        mixs[(size_t)b * 1024 + 512 + h * 64 + tid] = (bf16_t)(cvt_pk_bf16(y, 0.f) & 0xffffu);
    }
    __syncthreads();
}
__device__ __forceinline__ void s_c(const float* zs, const float* sc0  , float* sco, const float* cwg, const float* cbias, const float* cnorm, bf16_t* mixs,
                                    int b, int h, unsigned char* smem, int tid, int wave, int lane) {
    float* po = (float*)smem;
    const float* zr = zs + (size_t)b * NPAD;
    const float vv = zr[3328 + h * 64 + lane];
    float op = 0.f;
#pragma unroll
    for (int kk = 0; kk < 4; ++kk) {
        const int k = 4 * wave + kk;
        float x = cbias[h * 32 + k];
#pragma unroll
        for (int r = 0; r < 16; ++r) x += zr[3840 + r] * cwg[r * 128 + h * 32 + k];
        const float f = logsig16_exp(x);
        const size_t si = (((size_t)b * 4 + h) * 32 + k) * 64 + lane;
        const float s1 = f * sc0[si] + zr[3200 + h * 32 + k] * vv;
        sco[si] = s1;
        op += zr[3072 + h * 32 + k] * 0.17677669529663687f * s1;
    }
    po[wave * 64 + lane] = op;
    __syncthreads();
    if (tid < 64) {
        float o = 0.f;
#pragma unroll
        for (int w = 0; w < 8; ++w) o += po[w * 64 + tid];
        const float ss = wave_sum(o * o);
        const float y = o * rsqrtf(ss * (1.0f / 64.0f) + RMS_EPS) * cnorm[h * 64 + tid] * fsilu(zr[3584 + h * 64 + tid]);
        mixs[(size_t)b * 1024 + 768 + h * 64 + tid] = (bf16_t)(cvt_pk_bf16(y, 0.f) & 0xffffu);
    }
    __syncthreads();
}

#define LAS __attribute__((address_space(3)))
#define XB_TMO      128
#define XB_XCNT(j)  (256  + 64 * (j))
#define XB_XSUB(j)  (1280 + 64 * (j))
#define XB_XGEN(j)  (2304 + 64 * (j))
#define XB_TOP      3328
#define XB_TOPGEN   3392
#define XCD_BAR_WORDS 3456
#define XB_SPIN_CAP (1u << 18)

__device__ __forceinline__ unsigned xb_ld(unsigned* p)              { return __hip_atomic_load(p, __ATOMIC_RELAXED, __HIP_MEMORY_SCOPE_AGENT); }
__device__ __forceinline__ unsigned xb_add(unsigned* p, unsigned v) { return __hip_atomic_fetch_add(p, v, __ATOMIC_RELAXED, __HIP_MEMORY_SCOPE_AGENT); }
__device__ __forceinline__ unsigned xb_xcc_id() { return (unsigned)__builtin_amdgcn_s_getreg((3 << 11) | 20) & 0xFu; }
#define XB_SPIN(cond, bar) do { unsigned _sp = 0; while (cond) { __builtin_amdgcn_s_sleep(1); \
    if ((++_sp & 255u) == 0u) { if (xb_ld(&(bar)[XB_TMO])) break; if (_sp > XB_SPIN_CAP) { atomicAdd(&(bar)[XB_TMO], 1u); break; } } } } while (0)

struct XcdBarrier {
    unsigned* bar; unsigned x;
    volatile LAS unsigned* st;
};

__device__ __forceinline__ XcdBarrier xcd_barrier_post(unsigned* bar, volatile LAS unsigned* st, bool is_t0) {
    XcdBarrier b; b.bar = bar; b.x = xb_xcc_id(); b.st = st;
    if (is_t0) (void)xb_add(&bar[XB_XCNT(b.x)], 1u);
    return b;
}
__device__ __forceinline__ void xcd_barrier_complete(unsigned* bar, unsigned x, unsigned& nloc, unsigned& nx) {
    const unsigned G = gridDim.x * gridDim.y * gridDim.z;
    unsigned sum, cnt, mine, sp = 0u;
    for (;;) {
        sum = 0u; cnt = 0u; mine = 0u;
#pragma unroll
        for (unsigned j = 0; j < 16; ++j) { const unsigned c = xb_ld(&bar[XB_XCNT(j)]); sum += c; cnt += (c > 0u) ? 1u : 0u; mine = (j == x) ? c : mine; }
        if (sum == G) break;
        __builtin_amdgcn_s_sleep(1);
        if ((++sp & 255u) == 0u) { if (xb_ld(&bar[XB_TMO])) break; if (sp > XB_SPIN_CAP) { atomicAdd(&bar[XB_TMO], 1u); break; } }
    }
    nloc = mine > 0u ? mine : 1u; nx = cnt > 0u ? cnt : 1u;
}

__device__ __forceinline__ void xcd_barrier(const XcdBarrier& b, bool is_t0) {
    asm volatile("s_waitcnt vmcnt(0)" ::: "memory");
    __syncthreads();
    if (is_t0) {
        unsigned* bar = b.bar;
        __builtin_amdgcn_s_waitcnt(0);
        unsigned nloc = b.st[0], nx = b.st[1];
        if (nloc == 0u) { xcd_barrier_complete(bar, b.x, nloc, nx); b.st[0] = nloc; b.st[1] = nx; }
        const unsigned old = xb_add(&bar[XB_XSUB(b.x)], 1u);
        const unsigned gen = old / nloc;
        if (old + 1u == (gen + 1u) * nloc) {
            __builtin_amdgcn_fence(__ATOMIC_RELEASE, "agent");
            asm volatile("s_waitcnt vmcnt(0)" ::: "memory");
            const unsigned og = xb_add(&bar[XB_TOP], 1u);
            const unsigned tg = og / nx;
            if (og + 1u == (tg + 1u) * nx) xb_add(&bar[XB_TOPGEN], 1u);
            else XB_SPIN(xb_ld(&bar[XB_TOPGEN]) == tg, bar);
            __builtin_amdgcn_fence(__ATOMIC_ACQUIRE, "agent");
            xb_add(&bar[XB_XGEN(b.x)], 1u);
            asm volatile("s_waitcnt vmcnt(0)" ::: "memory");
        } else {
            XB_SPIN(xb_ld(&bar[XB_XGEN(b.x)]) == gen, bar);
            __builtin_amdgcn_fence(__ATOMIC_ACQUIRE, "agent");
            asm volatile("s_waitcnt vmcnt(0)" ::: "memory");
        }
    }
    __syncthreads();
}

#ifndef REP_ATT
#define REP_ATT 1
#endif
#ifndef REP_BL
#define REP_BL 1
#endif
#ifndef REP_SMP
#define REP_SMP 1
#endif
#ifndef REP_BO
#define REP_BO 1
#endif
#ifndef REP_CO
#define REP_CO 1
#endif
#ifndef REP_MRG
#define REP_MRG 1
#endif
#ifndef REP_P4
#define REP_P4 1
#endif
#ifndef REP_P6
#define REP_P6 1
#endif
#ifndef REP_G1
#define REP_G1 1
#endif
#ifndef REP_P0
#define REP_P0 1
#endif
#ifndef REP_G3
#define REP_G3 1
#endif
#ifndef REP_SCANPROBE
#define REP_SCANPROBE 1
#endif
#ifndef EN_ATT
#define EN_ATT 1
#endif
#ifndef EN_BL
#define EN_BL 1
#endif
#ifndef EN_CL
#define EN_CL 1
#endif
#ifndef EN_BO
#define EN_BO 1
#endif
#ifndef EN_CO
#define EN_CO 1
#endif
#ifndef EN_EPIPROJ
#define EN_EPIPROJ 1
#endif
#ifndef EN_EPIACT
#define EN_EPIACT 1
#endif
#ifndef EN_EPISTASH
#define EN_EPISTASH 1
#endif
#ifndef EN_EPIPLE
#define EN_EPIPLE 1
#endif
#ifndef EN_EPIRES
#define EN_EPIRES 1
#endif


__device__ __forceinline__ int owave(int w) { asm volatile("" : "+s"(w)); return __builtin_amdgcn_readfirstlane(w); }
__device__ __forceinline__ int olane() { int t = (int)__builtin_amdgcn_mbcnt_hi(~0u, __builtin_amdgcn_mbcnt_lo(~0u, 0u)); asm volatile("" : "+v"(t)); return t; }
typedef const Args __attribute__((address_space(4)))* KArgP;
__device__ __forceinline__ KArgP kargs_ptr() { KArgP p = (KArgP)__builtin_amdgcn_kernarg_segment_ptr(); asm volatile("" : "+s"(p)); return p; }
__global__ void __launch_bounds__(NTHR, 2) mega_fwd(Args args) {
    extern __shared__ __attribute__((aligned(16))) unsigned char smem[];
    cg::grid_group grid = cg::this_grid();
    const int wv0 = __builtin_amdgcn_readfirstlane((int)threadIdx.x >> 6);
    __builtin_assume(gridDim.x <= 1024u); __builtin_assume(blockIdx.x < gridDim.x);
#define tid  (owave(wv0) * 64 + olane())
#define lane (olane())
#define wave (owave(wv0))
#define G    ((int)gridDim.x)
#define bid  ((int)blockIdx.x)
#define gw   (bid * NWAVES + wave)
#define NGW  (G * NWAVES)
#define gt   (bid * NTHR + tid)
#define NGT  (G * NTHR)
#define KWS_EARLY (kargs_ptr()->ws)
    {
        volatile LAS unsigned* st0 = (volatile LAS unsigned*)((LAS unsigned char*)smem + 131072 + 256);
        if (threadIdx.x < 2) st0[threadIdx.x] = 0u;
        __syncthreads();
        (void)xcd_barrier_post((unsigned*)(KWS_EARLY + WS_BAR), st0, threadIdx.x == 0);
    }
#define GSYNC() do { XcdBarrier b_; b_.bar = (unsigned*)(KWS + WS_BAR); b_.x = xb_xcc_id(); b_.st = (volatile LAS unsigned*)((LAS unsigned char*)smem + 131072 + 256); xcd_barrier(b_, wv0 == 0 && olane() == 0); } while (0)
#define ldsg ((PG8_LAS unsigned char*)smem)
#define part0 ((float*)smem)
#define part1 (part0 + PART_FLOATS)
#define KIN(i) (kargs_ptr()->in[i])
#define KWS    (kargs_ptr()->ws)
#define KOUT   (kargs_ptr()->out)
#define H      (KOUT + O_YP)
#define HS     (KOUT + O_YS)
#define HB0    ((bf16_t*)(KWS + WS_HB0))
#define HB1    ((bf16_t*)(KWS + WS_HB1))
#define ACT    ((bf16_t*)(KWS + WS_ACT))
#define QB     ((bf16_t*)(KWS + WS_QB))
#define KB     ((bf16_t*)(KWS + WS_KB))
#define VB     ((bf16_t*)(KWS + WS_VB))
#define ZF     ((float*)(KWS + WS_ZF))
#define OC     ((bf16_t*)(KWS + WS_OC))
#define LSE    ((float*)(KWS + WS_LSE))
#define MIX    ((bf16_t*)(KWS + WS_MIX))
#define PB     ((bf16_t*)(KWS + WS_PB))
#define UB     ((float*)(KWS + WS_UB))
#define UC     ((float*)(KWS + WS_UC))
#define AB     ((float*)(KWS + WS_AB))
#define AC     ((float*)(KWS + WS_AC))
#define SSQ0   ((float*)(KWS + WS_SSQ0))
#define SSQ1   ((float*)(KWS + WS_SSQ1))
#define PP     ((float*)(KWS + WS_PP))
#define LB     ((float*)(KWS + WS_LB))
#define HSB0   ((bf16_t*)(KWS + WS_HSB0))
#define HSB1   ((bf16_t*)(KWS + WS_HSB1))
#define ACTS   ((bf16_t*)(KWS + WS_ACTS))
#define ZS     ((float*)(KWS + WS_ZS))
#define MIXS   ((bf16_t*)(KWS + WS_MIXS))
#define PSB    ((bf16_t*)(KWS + WS_PSB))
#define SSQS0  ((float*)(KWS + WS_SSQS0))
#define SSQS1  ((float*)(KWS + WS_SSQS1))
#define WLP(l, off) (KWS + WS_W + (size_t)(l) * WL_SIZE + (off))

    {
        float* scr = (float*)(smem + wave * 16384);
        constexpr int I_GU = 16 * 88, I_DN = 44 * 32, I_IN = 16 * 121, I_SQ = 16 * 32, I_PP = 4 * 32;
        constexpr int PER_L = 2 * I_GU + I_DN + I_IN + I_SQ + 2 * I_GU + I_DN + I_SQ + I_PP;
        for (int it = gw; it < 2 * PER_L; it += NGW) {
            const int l = it / PER_L; int r = it % PER_L;
            unsigned char* wl = WLP(l, 0);
            if (r < I_GU) { tr_item(KIN(9) + (size_t)l * DM * FF, DM, FF, KIN(8) + l * DM, (bf16_t*)(wl + WL_W1GU), 1, scr, r, lane); continue; } r -= I_GU;
            if (r < I_GU) { tr_item(KIN(10) + (size_t)l * DM * FF, DM, FF, KIN(8) + l * DM, (bf16_t*)(wl + WL_W1GU), 2, scr, r, lane); continue; } r -= I_GU;
            if (r < I_DN) { tr_item(KIN(11) + (size_t)l * FF * DM, FF, DM, nullptr, (bf16_t*)(wl + WL_W1D), 0, scr, r, lane); continue; } r -= I_DN;
            if (r < I_IN) { tr_item(KIN(13) + (size_t)l * DM * PW, DM, PW, KIN(12) + l * DM, (bf16_t*)(wl + WL_WIN), 3, scr, r, lane); continue; } r -= I_IN;
            if (r < I_SQ) { tr_item(KIN(19) + (size_t)l * DM * DM, DM, DM, nullptr, (bf16_t*)(wl + WL_WOUT), 0, scr, r, lane); continue; } r -= I_SQ;
            if (r < I_GU) { tr_item(KIN(21) + (size_t)l * DM * FF, DM, FF, KIN(20) + l * DM, (bf16_t*)(wl + WL_W2GU), 1, scr, r, lane); continue; } r -= I_GU;
            if (r < I_GU) { tr_item(KIN(22) + (size_t)l * DM * FF, DM, FF, KIN(20) + l * DM, (bf16_t*)(wl + WL_W2GU), 2, scr, r, lane); continue; } r -= I_GU;
            if (r < I_DN) { tr_item(KIN(23) + (size_t)l * FF * DM, FF, DM, nullptr, (bf16_t*)(wl + WL_W2D), 0, scr, r, lane); continue; } r -= I_DN;
            if (r < I_SQ) { tr_item(KIN(25) + (size_t)l * DM * DM, DM, DM, KIN(24) + l * DM, (bf16_t*)(wl + WL_WPG), 0, scr, r, lane); continue; } r -= I_SQ;
            tr_item(KIN(26) + (size_t)l * 256 * DM, 256, DM, nullptr, (bf16_t*)(wl + WL_WPP), 0, scr, r, lane);
        }
        for (int i = gt; i < 2 * 30720; i += NGT) { const int l = i / 30720, j = i % 30720;
            *(u32x4*)(WLP(l, WL_WIN) + (size_t)PW * DM * 2 + (size_t)j * 16) = (u32x4){0u, 0u, 0u, 0u}; }
        for (int row = gw; row < T + NS; row += NGW) {
            const bool smp = row >= T; const int rr = smp ? row - T : row;
            const float* xr = (smp ? KIN(1) : KIN(0)) + (size_t)rr * DM;
            float* hr = (smp ? HS : H) + (size_t)rr * DM; bf16_t* br = (smp ? HSB0 : HB0) + (size_t)rr * DM;
            float s = 0.f; f32x4 xv[4];
#pragma unroll
            for (int j = 0; j < 4; ++j) xv[j] = *(const f32x4*)(xr + 256 * j + 4 * lane);
#pragma unroll
            for (int j = 0; j < 4; ++j) { const f32x4 v = xv[j]; if (smp) *(f32x4*)(hr + 256 * j + 4 * lane) = v;
                u32x2 w; w.x = cvt_pk_bf16(v[0], v[1]); w.y = cvt_pk_bf16(v[2], v[3]); *(u32x2*)(br + 256 * j + 4 * lane) = w;
                s += (v[0] * v[0] + v[1] * v[1]) + (v[2] * v[2] + v[3] * v[3]); }
            s = wave_sum(s);
            if (smp) { if (lane < 32) SSQS0[rr * 32 + lane] = (lane == 0) ? s : 0.f; }
            else     { if (lane < 16) SSQ0[(size_t)rr * 16 + lane] = (lane == 0) ? s : 0.f; }
        }
        for (int i0 = gt; i0 < 2 * T * 256 / 8; i0 += 4 * NGT) { f32x4 pa[4], pb[4];
#pragma unroll
            for (int q = 0; q < 4; ++q) { const int i = i0 + q * NGT; const float* p = KIN(6) + (size_t)(i < 2 * T * 256 / 8 ? i : i0) * 8; pa[q] = *(const f32x4*)p; pb[q] = *(const f32x4*)(p + 4); }
#pragma unroll
            for (int q = 0; q < 4; ++q) { const int i = i0 + q * NGT; if (i < 2 * T * 256 / 8) *(u32x4*)(PB + (size_t)i * 8) = pg8::pack8(pa[q], pb[q]); } }
        for (int i = gt; i < 2 * NS * 256 / 8; i += NGT) { const float* p = KIN(7) + (size_t)i * 8; const f32x4 a = *(const f32x4*)p, b = *(const f32x4*)(p + 4); *(u32x4*)(PSB + (size_t)i * 8) = pg8::pack8(a, b); }
        if (gt < 512) { const float l0 = KIN(14)[gt], l1 = KIN(14)[512 + gt], m = fmaxf(l0, l1), e0 = __expf(l0 - m), e1 = __expf(l1 - m), s0 = e0 / (e0 + e1), s1 = e1 / (e0 + e1);
            LB[gt] = fmaxf(s0 - s0, 0.f); LB[512 + gt] = fmaxf((s0 + s1) - s0, 0.f); }
    }
    if (KWS == nullptr) grid.sync();
    GSYNC();

    for (int l = 0; l < 2; ++l) {
#define W1GU ((const bf16_t*)WLP(l, WL_W1GU))
#define W1D  ((const bf16_t*)WLP(l, WL_W1D))
#define WIN  ((const bf16_t*)WLP(l, WL_WIN))
#define WOUT ((const bf16_t*)WLP(l, WL_WOUT))
#define W2GU ((const bf16_t*)WLP(l, WL_W2GU))
#define W2D  ((const bf16_t*)WLP(l, WL_W2D))
#define WPG  ((const bf16_t*)WLP(l, WL_WPG))
#define WPP  ((const bf16_t*)WLP(l, WL_WPP))
#define WGU ((const bf16_t*)WLP(l, ffn ? WL_W2GU : WL_W1GU))
#define WD  ((const bf16_t*)WLP(l, ffn ? WL_W2D : WL_W1D))
#define lbl   (LB + l * 512)
#define bnorm (KIN(15) + l * 256)
#define cwg   (KIN(16) + l * 16 * 128)
#define cbias (KIN(17) + l * 128)
#define cnorm (KIN(18) + l * 256)
        for (int ffn = 0; ffn < 2; ++ffn) {
            if (ffn == 1) {
                {
                    pg8::Gemm g{HB1, WIN, T, NPAD, DM}; pg8::StaticOrder S; S.init(T, NPAD, G, bid);
                    pg8::EpiProj E{KWS, KOUT, l, WS_SSQ1, WS_QB, WS_KB, WS_VB, WS_ZF, O_KAP, O_VAP};

#if EN_EPIPROJ
pg8::gemm_phase<pg8::EpiProj, pg8::StaticOrder, true, true>(ldsg, g, S, E, wv0);
#endif

                    __syncthreads();
                    for (int tile = bid; tile < 121; tile += G) {
                        sgemm_tile(HSB1, WIN, DM, 32 * tile, part0, wave, lane);
                        __syncthreads();
                        { const int row = tid >> 4, c0 = (tid & 15) * 2; const float r = row_rinv32(SSQS1, row);
                          ZS[(size_t)row * NPAD + 32 * tile + c0] = part_sum(part0, row, c0) * r; ZS[(size_t)row * NPAD + 32 * tile + c0 + 1] = part_sum(part0, row, c0 + 1) * r; }
                        __syncthreads();
                    }
                }
                GSYNC();
                {

#if EN_ATT
                    {
                        if (wave >= 4) { for (int task = (wave - 4) * G + bid; task < NCH * 4; task += 4 * G) c_task<false>(ZF, (float*)(KWS + WS_FCB), cwg, cbias, UC, AC, cnorm, MIX, task >> 2, task & 3, (float*)(smem + wave * 14336), lane); }
                        const int q = (3 * 8 * 512) / NGW, rm = (3 * 8 * 512) % NGW, g = gw;
                        if (G == 256) attn_units(KWS, bid * 48 + (wave < 4 ? wave * 7 : 28 + (wave - 4) * 5), wave < 4 ? 7 : 5, smem + wave * 14336, lane);
                        else attn_units(KWS, g * q + (g < rm ? g : rm), q + (g < rm ? 1 : 0), smem + wave * 14336, lane);
                    }
#endif

                    __syncthreads();

#if EN_BL
{ int task = bid; do { b_local(ZF, lbl, UB, AB, task >> 2, task & 3, smem, tid, wave, lane); task += G; } while (task < NCHB * 4); }
#endif


#if EN_CL
;
#endif

                    __syncthreads();
                    for (int task = bid; task < 512; task += G) {
                        if (task < 256) s_attn(ZS, KIN(2) + (size_t)l * NS * 2048 * 512, KIN(3) + (size_t)l * NS * 2048 * 512, MIXS, KOUT + O_KAS + (size_t)l * NS * 512, KOUT + O_VAS + (size_t)l * NS * 512,
                                               task >> 3, task & 7, smem, tid, wave, lane);
                        else if (task < 384) s_b(ZS, KIN(4) + (size_t)l * NS * 32768, KOUT + O_SBS + (size_t)l * NS * 32768, lbl, bnorm, MIXS, (task - 256) >> 2, (task - 256) & 3, smem, tid, wave, lane);
                        else s_c(ZS, KIN(5) + (size_t)l * NS * 8192, KOUT + O_SCS + (size_t)l * NS * 8192, cwg, cbias, cnorm, MIXS, (task - 384) >> 2, (task - 384) & 3, smem, tid, wave, lane);
                    }
                }
                GSYNC();
                {
                    float* gA = (float*)smem; float* gU = gA + 8 * 64;
                    for (int task = bid; task < 640; task += G) {
                        const int e = task * 64 + lane; const bool isb = task < 512; const int ee = isb ? e : e - 32768;
                        float* U = isb ? UB : UC; const float* A = isb ? AB : AC; const int usz = isb ? 32768 : 8192, asz = isb ? 512 : 128;
                        const int g = wave, ak = ee >> 6; const bool act = !isb || g < NCHB / 32;
                        float u[32], a[32];
#pragma unroll
                        for (int i = 0; i < 32; ++i) { u[i] = 0.f; a[i] = 1.f; }
                        if (act) {
#pragma unroll
                            for (int i = 0; i < 32; ++i) { u[i] = U[(size_t)(32 * g + i) * usz + ee]; a[i] = A[(size_t)(32 * g + i) * asz + ak]; }
                        }
                        float sl = 0.f, c = 1.f;
#pragma unroll
                        for (int i = 0; i < 32; ++i) { const float ui = u[i], ai = a[i]; u[i] = sl; a[i] = c; sl = ai * sl + ui; c *= ai; }
                        gA[g * 64 + lane] = c; gU[g * 64 + lane] = sl;
                        __syncthreads();
                        float carry = 0.f;
                        for (int j = 0; j < g; ++j) carry = gA[j * 64 + lane] * carry + gU[j * 64 + lane];
#pragma unroll
                        for (int i = 0; i < 32; ++i) { if (act) U[(size_t)(32 * g + i) * usz + ee] = a[i] * carry + u[i]; }
                        if (g == 7) (isb ? KOUT + O_SBP + (size_t)l * 32768 : KOUT + O_SCP + (size_t)l * 8192)[ee] = c * carry + sl;
                        __syncthreads();
                    }
                }
                GSYNC();
                {

#if EN_BO
{ int task = bid; do { b_output(ZF, lbl, UB, bnorm, MIX, task >> 2, task & 3, smem, tid, wave, lane); task += G; } while (task < NCHB * 4); }
#endif


#if EN_CO
if (wave < 4 || G != 256) for (int task = wave * G + bid; task < NCH * 4; task += NGW) c_task<true>(ZF, (float*)(KWS + WS_FCB), cwg, cbias, UC, AC, cnorm, MIX, task >> 2, task & 3, (float*)(smem + wave * 14336), lane);
#endif

                    const bool mrg_half = (G == 256);
                    if (!mrg_half || wave >= 4) {
                        const int istr = mrg_half ? G * 256 : NGT;
                        for (int i0 = mrg_half ? bid * 256 + (tid - 256) : gt; i0 < T * 64; i0 += 4 * istr) {
                            float lw[4][3]; u32x4 va[4], vb[4], vc[4];
#pragma unroll
                            for (int q = 0; q < 4; ++q) { const int i = i0 + q * istr; const bool ok = i < T * 64; const int ii = ok ? i : i0;
                                const int t = ii >> 6, h = (ii >> 3) & 7, d8 = ii & 7; const size_t off = (size_t)t * 512 + h * 64 + d8 * 8;
                                lw[q][0] = LSE[((size_t)0 * T + t) * 8 + h]; lw[q][1] = LSE[((size_t)1 * T + t) * 8 + h]; lw[q][2] = LSE[((size_t)2 * T + t) * 8 + h];
                                va[q] = *(const u32x4*)(OC + off); vb[q] = *(const u32x4*)(OC + (size_t)T * 512 + off); vc[q] = *(const u32x4*)(OC + (size_t)2 * T * 512 + off); }
#pragma unroll
                            for (int q = 0; q < 4; ++q) { const int i = i0 + q * istr; if (i < T * 64) {
                                const int t = i >> 6, h = (i >> 3) & 7, d8 = i & 7;
                                const float l0 = lw[q][0], l1 = lw[q][1], l2 = lw[q][2];
                                const float m = fmaxf(l0, fmaxf(l1, l2)); float w0 = __expf(l0 - m), w1 = __expf(l1 - m), w2 = __expf(l2 - m); const float inv = 1.0f / (w0 + w1 + w2); w0 *= inv; w1 *= inv; w2 *= inv;
                                const u32x4 a = va[q], b = vb[q], c = vc[q];
                                u32x4 o;
#pragma unroll
                                for (int j = 0; j < 4; ++j) {
                                    const float lo = w0 * __uint_as_float(a[j] << 16) + w1 * __uint_as_float(b[j] << 16) + w2 * __uint_as_float(c[j] << 16);
                                    const float hi = w0 * __uint_as_float(a[j] & 0xffff0000u) + w1 * __uint_as_float(b[j] & 0xffff0000u) + w2 * __uint_as_float(c[j] & 0xffff0000u);
                                    o[j] = cvt_pk_bf16(lo, hi);
                                }
                                *(u32x4*)(MIX + (size_t)t * 1024 + h * 64 + d8 * 8) = o; } }
                        }
                    }
                }
                GSYNC();
                {
                    pg8::Gemm g{MIX, WOUT, T, DM, DM}; pg8::StaticOrder S; S.init(T, DM, G, bid);
                    pg8::EpiRes E{H, H, HB0, SSQ0, 1.0f};

#if EN_EPIRES
pg8::gemm_phase<pg8::EpiRes, pg8::StaticOrder, true, true>(ldsg, g, S, E, wv0);
#endif

                    __syncthreads();
                    for (int tile = bid; tile < 32; tile += G) {
                        sgemm_tile(MIXS, WOUT, DM, 32 * tile, part0, wave, lane);
                        __syncthreads();
                        { const int row = tid >> 4, c0 = (tid & 15) * 2; float* hp = HS + (size_t)row * DM + 32 * tile + c0;
                          const float h0 = hp[0] + part_sum(part0, row, c0), h1 = hp[1] + part_sum(part0, row, c0 + 1); hp[0] = h0; hp[1] = h1;
                          *(unsigned*)(HSB0 + (size_t)row * DM + 32 * tile + c0) = cvt_pk_bf16(h0, h1);
                          float ss = h0 * h0 + h1 * h1;
#pragma unroll
                          for (int o = 1; o < 16; o <<= 1) ss += __shfl_xor(ss, o);
                          if ((tid & 15) == 0) SSQS0[row * 32 + tile] = ss; }
                        __syncthreads();
                    }
                }
                GSYNC();
            }

            {
                pg8::Gemm g{HB0, WGU, T, 2 * FF, DM}; pg8::StaticOrder S; S.init(T, 2 * FF, G, bid);
                pg8::EpiAct E{SSQ0, ACT};

#if EN_EPIACT
pg8::gemm_phase<pg8::EpiAct, pg8::StaticOrder, true, true>(ldsg, g, S, E, wv0);
#endif

                __syncthreads();
                if (ffn == 1) {
                    pg8::Gemm g2{PB + (size_t)l * T * 256, WPP, T, DM, 256}; pg8::HalfOrder S2; S2.init(G, bid);
                    pg8::EpiStash E2{PP};
                    pg8::gemm_phase<pg8::EpiStash, pg8::HalfOrder, true, true>(ldsg, g2, S2, E2, wv0);
                    __syncthreads();
                }

                for (int pt = (G == 256) ? (bid >= 128 ? bid - 128 : 1 << 20) : bid; pt < 88; pt += G) {
                    const int n0 = 256 * (pt >> 2) + 32 * (pt & 3);
                    sgemm_tile(HSB0, WGU, DM, n0, part0, wave, lane);
                    sgemm_tile(HSB0, WGU, DM, n0 + 128, part1, wave, lane);
                    __syncthreads();
                    { const int row = tid >> 4, c0 = (tid & 15) * 2; const float r = row_rinv32(SSQS0, row);
                      const float g0 = part_sum(part0, row, c0) * r, g1 = part_sum(part0, row, c0 + 1) * r, u0 = part_sum(part1, row, c0) * r, u1 = part_sum(part1, row, c0 + 1) * r;
                      *(unsigned*)(ACTS + (size_t)row * FF + 32 * pt + c0) = cvt_pk_bf16(fsilu(g0) * u0, fsilu(g1) * u1); }
                    __syncthreads();
                }
            }
            GSYNC();
            {
                pg8::Gemm g{ACT, WD, T, DM, FF}; pg8::StaticOrder S; S.init(T, DM, G, bid);
                pg8::EpiRes E{(l == 0 && ffn == 0) ? KIN(0) : (const float*)H, H, HB1, SSQ1, 0.5f};

#if EN_EPIRES
pg8::gemm_phase<pg8::EpiRes, pg8::StaticOrder, true, true>(ldsg, g, S, E, wv0);
#endif

                __syncthreads();
                for (int tile = bid; tile < 32; tile += G) {
                    sgemm_tile(ACTS, WD, FF, 32 * tile, part0, wave, lane);
                    __syncthreads();
                    { const int row = tid >> 4, c0 = (tid & 15) * 2; float* hp = HS + (size_t)row * DM + 32 * tile + c0;
                      const float h0 = hp[0] + 0.5f * part_sum(part0, row, c0), h1 = hp[1] + 0.5f * part_sum(part0, row, c0 + 1); hp[0] = h0; hp[1] = h1;
                      *(unsigned*)(HSB1 + (size_t)row * DM + 32 * tile + c0) = cvt_pk_bf16(h0, h1);
                      float ss = h0 * h0 + h1 * h1;
#pragma unroll
                      for (int o = 1; o < 16; o <<= 1) ss += __shfl_xor(ss, o);
                      if ((tid & 15) == 0) SSQS1[row * 32 + tile] = ss; }
                    __syncthreads();
                }
            }
            GSYNC();
        }
        {
            { pg8::Gemm g{HB1, WPG, T, DM, DM}; pg8::StaticOrder S; S.init(T, DM, G, bid);
              pg8::EpiPle E{SSQ1, PP, H, HB0, SSQ0};

#if EN_EPIPLE
pg8::gemm_phase<pg8::EpiPle, pg8::StaticOrder, true, true>(ldsg, g, S, E, wv0);
#endif
 }
            __syncthreads();
            for (int tile = bid; tile < 32; tile += G) {
                sgemm_tile(PSB + (size_t)l * NS * 256, WPP, 256, 32 * tile, part0, wave, lane);
                sgemm_tile(HSB1, WPG, DM, 32 * tile, part1, wave, lane);
                __syncthreads();
                { const int row = tid >> 4, c0 = (tid & 15) * 2; float* hp = HS + (size_t)row * DM + 32 * tile + c0; const float r = row_rinv32(SSQS1, row);
                  const float h0 = hp[0] + fsigmoid(part_sum(part1, row, c0) * r) * part_sum(part0, row, c0), h1 = hp[1] + fsigmoid(part_sum(part1, row, c0 + 1) * r) * part_sum(part0, row, c0 + 1);
                  hp[0] = h0; hp[1] = h1;
                  *(unsigned*)(HSB0 + (size_t)row * DM + 32 * tile + c0) = cvt_pk_bf16(h0, h1);
                  float ss = h0 * h0 + h1 * h1;
#pragma unroll
                  for (int o = 1; o < 16; o <<= 1) ss += __shfl_xor(ss, o);
                  if ((tid & 15) == 0) SSQS0[row * 32 + tile] = ss; }
                __syncthreads();
            }
        }
        GSYNC();
    }
    {
        f32x4 gv[4];
#pragma unroll
        for (int j = 0; j < 4; ++j) gv[j] = *(const f32x4*)(KIN(27) + 256 * j + 4 * lane);
        for (int row0 = gw; row0 < T + NS; row0 += 4 * NGW) {
            f32x4 v[4][4]; float r[4];
#pragma unroll
            for (int q = 0; q < 4; ++q) { const int row = row0 + q * NGW; const bool ok = row < T + NS; const int rw = ok ? row : row0;
                const bool smp = rw >= T; const int rr = smp ? rw - T : rw;
                const float* hr = (smp ? HS : H) + (size_t)rr * DM;
#pragma unroll
                for (int j = 0; j < 4; ++j) v[q][j] = *(const f32x4*)(hr + 256 * j + 4 * lane);
                r[q] = smp ? row_rinv32(SSQS0, rr) : pg8::row_rinv16(SSQ0, rr); }
#pragma unroll
            for (int q = 0; q < 4; ++q) { const int row = row0 + q * NGW; if (row < T + NS) {
                const bool smp = row >= T; const int rr = smp ? row - T : row;
                float* hr = (smp ? HS : H) + (size_t)rr * DM;
#pragma unroll
                for (int j = 0; j < 4; ++j) *(f32x4*)(hr + 256 * j + 4 * lane) = v[q][j] * r[q] * gv[j]; } }
        }
    }
}

extern "C" void kernel_launch(void* const* d_in, const int* in_sizes, int n_in, void* d_out, int out_size, void* d_ws, size_t ws_size, hipStream_t stream) {
    static int grid = 0;
    if (grid == 0) {
        if (n_in != 28 || (size_t)out_size != O_END || ws_size < WS_END) { fprintf(stderr, "kernel_launch: unexpected shapes (n_in %d out %d ws %zu need %zu)\n", n_in, out_size, ws_size, (size_t)WS_END); grid = -1; return; }
        int dev = 0, cus = 0, per_cu = 0;
        if (hipGetDevice(&dev) != hipSuccess || hipDeviceGetAttribute(&cus, hipDeviceAttributeMultiprocessorCount, dev) != hipSuccess) { grid = -1; return; }
        if (hipFuncSetAttribute((const void*)mega_fwd, hipFuncAttributeMaxDynamicSharedMemorySize, LDS_BYTES) != hipSuccess) { fprintf(stderr, "kernel_launch: hipFuncSetAttribute failed\n"); grid = -1; return; }
        if (hipOccupancyMaxActiveBlocksPerMultiprocessor(&per_cu, (const void*)mega_fwd, NTHR, LDS_BYTES) != hipSuccess || per_cu < 1) { fprintf(stderr, "kernel_launch: occupancy query failed (%d)\n", per_cu); (void)hipGetLastError(); per_cu = 1; }
        grid = cus * 1;
        if (grid > cus * per_cu) grid = cus * per_cu;
    }
    if (grid < 0) return;
    if (hipMemsetAsync((unsigned char*)d_ws + WS_BAR, 0, WS_BAR_BYTES, stream) != hipSuccess) { fprintf(stderr, "kernel_launch: memset failed\n"); return; }
    Args a{};
    for (int i = 0; i < 28; ++i) a.in[i] = (const float*)d_in[i];
    a.out = (float*)d_out; a.ws = (unsigned char*)d_ws;
    void* kargs[] = {&a};
    hipError_t e = hipLaunchCooperativeKernel((const void*)mega_fwd, dim3(grid), dim3(NTHR), kargs, LDS_BYTES, stream);
    if (e != hipSuccess) fprintf(stderr, "kernel_launch: cooperative launch failed: %s (grid %d)\n", hipGetErrorString(e), grid);
}
```

```cpp
#include <hip/hip_runtime.h>
#include <hip/hip_cooperative_groups.h>
#include <cstdio>
#include <cstdint>
namespace cg = cooperative_groups;
namespace pg8 {
#define PG8_LAS __attribute__((address_space(3)))
typedef unsigned short bf16_t;
typedef short bf16x8 __attribute__((ext_vector_type(8)));
typedef float f32x4 __attribute__((ext_vector_type(4)));
typedef unsigned u32x4 __attribute__((ext_vector_type(4)));
constexpr int BM = 256, BK = 64, HALF = 128, HTB = HALF * BK * 2  , STAGE_BYTES = 8 * HTB, NXCD = 8, WGM = 8;

__host__ __device__ __forceinline__ int lds_byte(int r, int c) { const int st = (r >> 4) * 2 + (c >> 5), rr = r & 15, cc = c & 31, ob = rr * 64 + cc * 2; return st * 1024 + (ob ^ (((ob >> 9) & 1) << 5)); }
__host__ __device__ __forceinline__ void stage_rc(int b, int& R, int& C) { const int st = b / 1024, sb = b % 1024, swz = sb ^ (((sb >> 9) & 1) << 5); R = (st >> 1) * 16 + swz / 64; C = (st & 1) * 32 + (swz % 64) / 2; }
__host__ __device__ __forceinline__ int perm32(int rho) { const int n = rho >> 4, i = rho & 15; return 8 * (i >> 2) + 4 * n + (i & 3); }

struct Unit { int pm, pn; };
struct Gemm { const bf16_t* A; const bf16_t* Bt; int M, N, K; };

struct StaticOrder {
    int nM, nN, nwg, G, c;
    __host__ __device__ void init(int M, int N, int G_, int c_) { nM = M / BM; nN = N / BM; nwg = nM * nN; G = G_; c = c_; }
    __host__ __device__ bool next(int i, Unit& u) const {
        const long L = (long)i * G + c; if (L >= nwg) return false;
        int wgid = (int)L; { const int q = nwg / NXCD, r = nwg % NXCD, xcd = wgid % NXCD, off = wgid / NXCD; wgid = (xcd < r ? xcd * (q + 1) : r * (q + 1) + (xcd - r) * q) + off; }
        const int nig = WGM * nN, gid = wgid / nig, fm = gid * WGM, gsz = (nM - fm) < WGM ? (nM - fm) : WGM;
        u.pm = fm + ((wgid % nig) % gsz); u.pn = (wgid % nig) / gsz; return true;
    }
    __device__ __forceinline__ void a_ready(const Unit&) const {}
    __device__ __forceinline__ void done(const Unit&) const {}
};

struct HalfOrder {
    int c, nblk;
    __host__ __device__ void init(int G_, int c_) { nblk = G_ - G_ / 2; c = c_ - G_ / 2; }
    __host__ __device__ bool next(int i, Unit& u) const { if (c < 0) return false; const int L = i * nblk + c; if (L >= 256) return false; u.pm = L >> 2; u.pn = L & 3; return true; }
    __device__ __forceinline__ void a_ready(const Unit&) const {}
    __device__ __forceinline__ void done(const Unit&) const {}
};

__device__ __forceinline__ unsigned cvt_pk_bf16(float lo, float hi) { unsigned r; asm volatile("v_cvt_pk_bf16_f32 %0, %1, %2" : "=v"(r) : "v"(lo), "v"(hi)); return r; }

typedef float f32x16 __attribute__((ext_vector_type(16)));
constexpr float RMS_EPS = 1e-6f;
__device__ __forceinline__ float fsigmoid(float x) { return __builtin_amdgcn_rcpf(1.0f + __builtin_amdgcn_exp2f(x * -1.4426950408889634f)); }
__device__ __forceinline__ float fsilu(float x) { return x * __builtin_amdgcn_rcpf(1.0f + __builtin_amdgcn_exp2f(x * -1.4426950408889634f)); }
__device__ __forceinline__ float row_rinv16(const float* ssq, int row) {
    const f32x4* p = (const f32x4*)(ssq + (size_t)row * 16);
    const f32x4 a = p[0], b = p[1], c = p[2], d = p[3];
    const float s = ((a[0] + a[1]) + (a[2] + a[3])) + ((b[0] + b[1]) + (b[2] + b[3])) + ((c[0] + c[1]) + (c[2] + c[3])) + ((d[0] + d[1]) + (d[2] + d[3]));
    return rsqrtf(s * (1.0f / 1024.0f) + RMS_EPS);
}
__device__ __forceinline__ u32x4 pack8(const f32x4 a, const f32x4 b) {
    u32x4 w; w.x = cvt_pk_bf16(a[0], a[1]); w.y = cvt_pk_bf16(a[2], a[3]); w.z = cvt_pk_bf16(b[0], b[1]); w.w = cvt_pk_bf16(b[2], b[3]); return w;
}

template <int NB  >
__device__ __forceinline__ void rinv8(const float* ssq, int row0, float (&r)[8]) {
#pragma unroll
    for (int b = 0; b < 8 / NB; ++b) {
        f32x4 p[NB][4];
#pragma unroll
        for (int mm = 0; mm < NB; ++mm) { const int i = b * NB + mm, ai = i >> 2, m = i & 3;
#pragma unroll
            for (int q = 0; q < 4; ++q) p[mm][q] = *(const f32x4*)(ssq + (size_t)(row0 + ai * HALF + m * 16) * 16 + 4 * q); }
#pragma unroll
        for (int mm = 0; mm < NB; ++mm) {
            const f32x4 a = p[mm][0], bb = p[mm][1], c = p[mm][2], d = p[mm][3];
            const float s = ((a[0] + a[1]) + (a[2] + a[3])) + ((bb[0] + bb[1]) + (bb[2] + bb[3])) + ((c[0] + c[1]) + (c[2] + c[3])) + ((d[0] + d[1]) + (d[2] + d[3]));
            r[b * NB + mm] = rsqrtf(s * (1.0f / 1024.0f) + RMS_EPS);
        }
        asm volatile("" ::: "memory");
    }
}

struct EpiAct {
    static constexpr bool PERM = true, AFTER_DRAIN = false;
    const float* ssq; bf16_t* act;
    __device__ __forceinline__ void operator()(const f32x4 (&acc)[2][2][4][2], const Unit& u, int wr, int wc, int fr, int fq) const {
        const int colo = u.pn * 128 + wc * 32 + 8 * fq;
        f32x4 pc[4];
#pragma unroll
        for (int q = 0; q < 4; ++q) pc[q] = *(const f32x4*)(ssq + (size_t)(u.pm * BM + wr * 64 + fr) * 16 + 4 * q);
#pragma unroll
        for (int ai = 0; ai < 2; ++ai)
#pragma unroll
            for (int m = 0; m < 4; ++m) {
                const int row = u.pm * BM + ai * HALF + wr * 64 + m * 16 + fr;
                f32x4 pn[4];
                { const int g1 = (ai * 4 + m + 1) & 7, rown = u.pm * BM + (g1 >> 2) * HALF + wr * 64 + (g1 & 3) * 16 + fr;
#pragma unroll
                  for (int q = 0; q < 4; ++q) pn[q] = *(const f32x4*)(ssq + (size_t)rown * 16 + 4 * q); }
                const float r = rsqrtf((((pc[0][0] + pc[0][1]) + (pc[0][2] + pc[0][3])) + ((pc[1][0] + pc[1][1]) + (pc[1][2] + pc[1][3])) + ((pc[2][0] + pc[2][1]) + (pc[2][2] + pc[2][3])) + ((pc[3][0] + pc[3][1]) + (pc[3][2] + pc[3][3]))) * (1.0f / 1024.0f) + RMS_EPS);
#pragma unroll
                for (int q = 0; q < 4; ++q) pc[q] = pn[q];
                f32x4 o[2];
#pragma unroll
                for (int n = 0; n < 2; ++n) {
                    const f32x4 g = acc[ai][0][m][n] * r, up = acc[ai][1][m][n] * r;
#pragma unroll
                    for (int j = 0; j < 4; ++j) o[n][j] = fsilu(g[j]) * up[j];
                }
                *(u32x4*)(act + (size_t)row * 2816 + colo) = pack8(o[0], o[1]);
                asm volatile("" ::: "memory");
            }
    }
};
struct EpiRes {
    static constexpr bool PERM = true, AFTER_DRAIN = false;
    const float* hin; float* h; bf16_t* hb; float* ssq_out; float scale;
    __device__ __forceinline__ void operator()(const f32x4 (&acc)[2][2][4][2], const Unit& u, int wr, int wc, int fr, int fq) const {
#pragma unroll
        for (int ai = 0; ai < 2; ++ai) {
            f32x4 hv[4][2][2];
#pragma unroll
            for (int m = 0; m < 4; ++m)
#pragma unroll
                for (int bj = 0; bj < 2; ++bj) { const float* hp = hin + (size_t)(u.pm * BM + ai * HALF + wr * 64 + m * 16 + fr) * 1024 + u.pn * BM + bj * HALF + wc * 32 + 8 * fq;
                    hv[m][bj][0] = *(const f32x4*)hp; hv[m][bj][1] = *(const f32x4*)(hp + 4); }
#pragma unroll
            for (int m = 0; m < 4; ++m) {
                const int row = u.pm * BM + ai * HALF + wr * 64 + m * 16 + fr;
                float ss = 0.f;
#pragma unroll
                for (int bj = 0; bj < 2; ++bj) {
                    const int col0 = u.pn * BM + bj * HALF + wc * 32 + 8 * fq;
                    float* hp = h + (size_t)row * 1024 + col0;
                    const f32x4 h0 = hv[m][bj][0] + acc[ai][bj][m][0] * scale, h1 = hv[m][bj][1] + acc[ai][bj][m][1] * scale;
                    *(f32x4*)hp = h0; *(f32x4*)(hp + 4) = h1;
                    *(u32x4*)(hb + (size_t)row * 1024 + col0) = pack8(h0, h1);
                    ss += (h0[0] * h0[0] + h0[1] * h0[1]) + (h0[2] * h0[2] + h0[3] * h0[3]) + (h1[0] * h1[0] + h1[1] * h1[1]) + (h1[2] * h1[2] + h1[3] * h1[3]);
                }
                ss += __shfl_xor(ss, 16); ss += __shfl_xor(ss, 32);
                if (fq == 0) ssq_out[(size_t)row * 16 + u.pn * 4 + wc] = ss;
            }
            asm volatile("" ::: "memory");
        }
    }
};
struct EpiStash {
    static constexpr bool PERM = true, AFTER_DRAIN = false;
    float* pp;
    __device__ __forceinline__ void operator()(const f32x4 (&acc)[2][2][4][2], const Unit& u, int wr, int wc, int fr, int fq) const {
#pragma unroll
        for (int ai = 0; ai < 2; ++ai)
#pragma unroll
            for (int m = 0; m < 4; ++m) {
                const int row = u.pm * BM + ai * HALF + wr * 64 + m * 16 + fr;
#pragma unroll
                for (int bj = 0; bj < 2; ++bj) {
                    float* p = pp + (size_t)row * 1024 + u.pn * BM + bj * HALF + wc * 32 + 8 * fq;
                    *(f32x4*)p = acc[ai][bj][m][0]; *(f32x4*)(p + 4) = acc[ai][bj][m][1];
                }
                asm volatile("" ::: "memory");
            }
    }
};
struct EpiPle {
    static constexpr bool PERM = true, AFTER_DRAIN = false;
    const float* ssq_in; const float* pp; float* h; bf16_t* hb; float* ssq_out;
    __device__ __forceinline__ void operator()(const f32x4 (&acc)[2][2][4][2], const Unit& u, int wr, int wc, int fr, int fq) const {
        f32x4 pc[4];
#pragma unroll
        for (int q = 0; q < 4; ++q) pc[q] = *(const f32x4*)(ssq_in + (size_t)(u.pm * BM + wr * 64 + fr) * 16 + 4 * q);
#pragma unroll
        for (int ai = 0; ai < 2; ++ai)
#pragma unroll
            for (int m = 0; m < 4; ++m) {
                const int row = u.pm * BM + ai * HALF + wr * 64 + m * 16 + fr;
                f32x4 pn[4];
                { const int g1 = (ai * 4 + m + 1) & 7, rown = u.pm * BM + (g1 >> 2) * HALF + wr * 64 + (g1 & 3) * 16 + fr;
#pragma unroll
                  for (int q = 0; q < 4; ++q) pn[q] = *(const f32x4*)(ssq_in + (size_t)rown * 16 + 4 * q); }
                f32x4 hv[2][2], pv[2][2];
#pragma unroll
                for (int bj = 0; bj < 2; ++bj) { const size_t off = (size_t)row * 1024 + u.pn * BM + bj * HALF + wc * 32 + 8 * fq;
                    hv[bj][0] = *(const f32x4*)(h + off); hv[bj][1] = *(const f32x4*)(h + off + 4); pv[bj][0] = *(const f32x4*)(pp + off); pv[bj][1] = *(const f32x4*)(pp + off + 4); }
                const float r = rsqrtf((((pc[0][0] + pc[0][1]) + (pc[0][2] + pc[0][3])) + ((pc[1][0] + pc[1][1]) + (pc[1][2] + pc[1][3])) + ((pc[2][0] + pc[2][1]) + (pc[2][2] + pc[2][3])) + ((pc[3][0] + pc[3][1]) + (pc[3][2] + pc[3][3]))) * (1.0f / 1024.0f) + RMS_EPS);
#pragma unroll
                for (int q = 0; q < 4; ++q) pc[q] = pn[q];
                float ss = 0.f;
#pragma unroll
                for (int bj = 0; bj < 2; ++bj) {
                    const int col0 = u.pn * BM + bj * HALF + wc * 32 + 8 * fq;
                    float* hp = h + (size_t)row * 1024 + col0;
                    f32x4 h0 = hv[bj][0], h1 = hv[bj][1];
#pragma unroll
                    for (int j = 0; j < 4; ++j) { h0[j] += fsigmoid(acc[ai][bj][m][0][j] * r) * pv[bj][0][j]; h1[j] += fsigmoid(acc[ai][bj][m][1][j] * r) * pv[bj][1][j]; }
                    *(f32x4*)hp = h0; *(f32x4*)(hp + 4) = h1;
                    *(u32x4*)(hb + (size_t)row * 1024 + col0) = pack8(h0, h1);
                    ss += (h0[0] * h0[0] + h0[1] * h0[1]) + (h0[2] * h0[2] + h0[3] * h0[3]) + (h1[0] * h1[0] + h1[1] * h1[1]) + (h1[2] * h1[2] + h1[3] * h1[3]);
                }
                ss += __shfl_xor(ss, 16); ss += __shfl_xor(ss, 32);
                if (fq == 0) ssq_out[(size_t)row * 16 + u.pn * 4 + wc] = ss;
                asm volatile("" ::: "memory");
            }
    }
};
struct EpiProj {
    static constexpr bool PERM = true, AFTER_DRAIN = false;
    unsigned char* ws; float* outp; int layer;
    size_t o_ssq, o_qb, o_kb, o_vb, o_zf, o_kap, o_vap;
    __device__ __forceinline__ void operator()(const f32x4 (&acc)[2][2][4][2], const Unit& u, int wr, int wc, int fr, int fq) const {
        const int c = wc * 32 + 8 * fq;
        const float* ssq = (const float*)(ws + o_ssq); bf16_t* Qb = (bf16_t*)(ws + o_qb); bf16_t* Kb = (bf16_t*)(ws + o_kb); bf16_t* Vb = (bf16_t*)(ws + o_vb);
        float* ZF = (float*)(ws + o_zf);
        float* kout = outp + o_kap + (size_t)layer * 2048 * 512; float* vout = outp + o_vap + (size_t)layer * 2048 * 512;
        f32x4 pc[4];
#pragma unroll
        for (int q = 0; q < 4; ++q) pc[q] = *(const f32x4*)(ssq + (size_t)(u.pm * BM + wr * 64 + fr) * 16 + 4 * q);
#pragma unroll
        for (int ai = 0; ai < 2; ++ai)
#pragma unroll
            for (int m = 0; m < 4; ++m) {
                const int row = u.pm * BM + ai * HALF + wr * 64 + m * 16 + fr;
                f32x4 pn[4];
                { const int g1 = (ai * 4 + m + 1) & 7, rown = u.pm * BM + (g1 >> 2) * HALF + wr * 64 + (g1 & 3) * 16 + fr;
#pragma unroll
                  for (int q = 0; q < 4; ++q) pn[q] = *(const f32x4*)(ssq + (size_t)rown * 16 + 4 * q); }
                const float r = rsqrtf((((pc[0][0] + pc[0][1]) + (pc[0][2] + pc[0][3])) + ((pc[1][0] + pc[1][1]) + (pc[1][2] + pc[1][3])) + ((pc[2][0] + pc[2][1]) + (pc[2][2] + pc[2][3])) + ((pc[3][0] + pc[3][1]) + (pc[3][2] + pc[3][3]))) * (1.0f / 1024.0f) + RMS_EPS);
#pragma unroll
                for (int q = 0; q < 4; ++q) pc[q] = pn[q];
#pragma unroll
                for (int bj = 0; bj < 2; ++bj) {
                    const int zc = u.pn * BM + bj * HALF;
                    f32x4 v0 = acc[ai][bj][m][0] * r, v1 = acc[ai][bj][m][1] * r;
                    if (zc < 1536) {
                        const int which = zc >> 9, cc = (zc & 511) + c;
                        if (which == 0) { v0 = v0 * 0.18033688011112042f; v1 = v1 * 0.18033688011112042f; }
                        bf16_t* dst = (which == 0 ? Qb : (which == 1 ? Kb : Vb)) + ((size_t)(cc >> 6) * 16384 + row) * 64 + (cc & 63);
                        *(u32x4*)dst = pack8(v0, v1);
                        if (which > 0 && row >= 16384 - 2048) {
                            float* o = (which == 1 ? kout : vout) + (size_t)(row - (16384 - 2048)) * 512 + cc;
                            *(f32x4*)o = v0; *(f32x4*)(o + 4) = v1;
                        }
                    } else {
                        float* o = ZF + (size_t)row * 2560 + (zc - 1536) + c;
                        *(f32x4*)o = v0; *(f32x4*)(o + 4) = v1;
                    }
                }
                asm volatile("" ::: "memory");
            }
    }
};
template <class Epi, class Sched, bool ALIGN_EPI = false, bool SP2 = false>
__device__ __forceinline__ void gemm_phase(PG8_LAS unsigned char* lds, const Gemm g, const Sched& S, const Epi& E, const int wid_in) {
    int tid_o = wid_in * 64 + (int)__builtin_amdgcn_mbcnt_hi(~0u, __builtin_amdgcn_mbcnt_lo(~0u, 0u)); asm volatile("" : "+v"(tid_o));
    const int tid = tid_o, wid = __builtin_amdgcn_readfirstlane(tid >> 6), lane = tid & 63, wr = wid >> 2, wc = wid & 3, fr = lane & 15, fq = lane >> 4;
    const int K = g.K, nt = K / BK;
    unsigned voffA[2], voffB[2];
#pragma unroll
    for (int i = 0; i < 2; ++i) { int R, C; stage_rc(tid * 16 + i * 8192, R, C); const int Rb = Epi::PERM ? ((R & ~31) + perm32(R & 31)) : R;
        voffA[i] = (unsigned)(R * K + C) * 2u; voffB[i] = (unsigned)(Rb * K + C) * 2u; }
    const size_t kstep = (size_t)(BK * 2);
    const size_t hstep = (size_t)HALF * K * 2;
    const size_t tstep = 2 * hstep;
    const unsigned ldsw = (unsigned)wid * 1024u;
    const int aoff = lds_byte(wr * 64 + fr, fq * 8), boff = lds_byte(wc * 32 + fr, fq * 8);
#define PG8_SA(b, h) (((b) * 2 + (h)) * HTB)
#define PG8_SB(b, h) ((4 + (b) * 2 + (h)) * HTB)
#define PG8_STAGE(bufoff, gbase, voff) do { _Pragma("unroll") for (int _i = 0; _i < 2; ++_i) \
        __builtin_amdgcn_global_load_lds((const unsigned*)((const char*)(gbase) + (voff)[_i]), (PG8_LAS unsigned*)(lds + (bufoff) + ldsw + _i * 8192), 16, 0, 0); } while (0)
#define PG8_LDA(dst, b, h) do { _Pragma("unroll") for (int m = 0; m < 4; ++m) _Pragma("unroll") for (int k = 0; k < 2; ++k) dst[m][k] = *(const PG8_LAS bf16x8*)(lds + PG8_SA(b, h) + aoff + m * 2048 + k * 1024); } while (0)
#define PG8_LDB(dst, b, h) do { _Pragma("unroll") for (int n = 0; n < 2; ++n) _Pragma("unroll") for (int k = 0; k < 2; ++k) dst[n][k] = *(const PG8_LAS bf16x8*)(lds + PG8_SB(b, h) + boff + n * 2048 + k * 1024); } while (0)
#define PG8_MMA(ai, bj, At, Bt) do { __builtin_amdgcn_s_setprio(1); _Pragma("unroll") for (int m = 0; m < 4; ++m) _Pragma("unroll") for (int n = 0; n < 2; ++n) _Pragma("unroll") for (int k = 0; k < 2; ++k) \
        acc[ai][bj][m][n] = __builtin_amdgcn_mfma_f32_16x16x32_bf16(Bt[n][k], At[m][k], acc[ai][bj][m][n], 0, 0, 0); __builtin_amdgcn_s_setprio(0); } while (0)
#define PG8_WAIT_V(n) asm volatile("s_waitcnt vmcnt(" #n ")" ::: "memory")
#define PG8_WAIT_L(n) asm volatile("s_waitcnt lgkmcnt(" #n ")" ::: "memory")
#define PG8_BAR __builtin_amdgcn_s_barrier()
#define PG8_SCHED __builtin_amdgcn_sched_barrier(0)
    Unit cur, nxt; int ui = 0;
    if (!S.next(0, cur)) return;
    f32x4 acc[2][2][4][2];
#pragma unroll
    for (int a = 0; a < 2; ++a)
#pragma unroll
        for (int b = 0; b < 2; ++b)
#pragma unroll
            for (int m = 0; m < 4; ++m)
#pragma unroll
                for (int n = 0; n < 2; ++n) acc[a][b][m][n] = (f32x4){0.f, 0.f, 0.f, 0.f};
    bf16x8 At[4][2], B0[2][2], B1[2][2];
    const char* cA = (const char*)g.A + (size_t)cur.pm * tstep; const char* cB = (const char*)g.Bt + (size_t)cur.pn * tstep;
    S.a_ready(cur);
    if constexpr (SP2) {
        PG8_STAGE(PG8_SB(0, 0), cB, voffB); PG8_STAGE(PG8_SB(0, 1), cB + hstep, voffB); PG8_STAGE(PG8_SA(0, 0), cA, voffA); PG8_STAGE(PG8_SA(0, 1), cA + hstep, voffA);
        if (wr == 1) PG8_BAR;
        PG8_WAIT_V(2); PG8_BAR;
        PG8_STAGE(PG8_SB(1, 0), cB + kstep, voffB); PG8_STAGE(PG8_SA(1, 0), cA + kstep, voffA); PG8_STAGE(PG8_SB(1, 1), cB + hstep + kstep, voffB);
        PG8_WAIT_V(6); PG8_BAR;
    } else {
        PG8_STAGE(PG8_SB(0, 0), cB, voffB); PG8_STAGE(PG8_SA(0, 0), cA, voffA); PG8_STAGE(PG8_SB(0, 1), cB + hstep, voffB); PG8_STAGE(PG8_SA(0, 1), cA + hstep, voffA);
        if (wr == 1) PG8_BAR;
        PG8_WAIT_V(4); PG8_BAR;
        PG8_STAGE(PG8_SB(1, 0), cB + kstep, voffB); PG8_STAGE(PG8_SA(1, 0), cA + kstep, voffA); PG8_STAGE(PG8_SB(1, 1), cB + hstep + kstep, voffB);
        PG8_WAIT_V(6); PG8_BAR;
    }
    for (;;) {
        const bool has_next = S.next(ui + 1, nxt);
        const char* nA = has_next ? (const char*)g.A + (size_t)nxt.pm * tstep : cA; const char* nB = has_next ? (const char*)g.Bt + (size_t)nxt.pn * tstep : cB;
#pragma unroll 1
        for (int t = 0; t < nt; t += 2) {
            const bool last = (t == nt - 2);
            const char* a1 = cA + (size_t)(t + 1) * kstep;
            const char* a2 = last ? nA : cA + (size_t)(t + 2) * kstep; const char* b2 = last ? nB : cB + (size_t)(t + 2) * kstep;
            const char* a3 = a2 + kstep; const char* b3 = b2 + kstep;
            if (last && has_next) S.a_ready(nxt);
            if constexpr (SP2) {
            PG8_LDB(B0, 0, 0); PG8_LDB(B1, 0, 1); PG8_SCHED; PG8_LDA(At, 0, 0); PG8_STAGE(PG8_SA(1, 1), a1 + hstep, voffA);
            PG8_WAIT_V(8); PG8_WAIT_L(0); PG8_BAR; PG8_MMA(0, 0, At, B0); PG8_MMA(0, 1, At, B1); PG8_BAR; PG8_SCHED;
            PG8_LDA(At, 0, 1); PG8_STAGE(PG8_SB(0, 0), b2, voffB); PG8_STAGE(PG8_SB(0, 1), b2 + hstep, voffB); PG8_STAGE(PG8_SA(0, 0), a2, voffA);
            PG8_WAIT_V(8); PG8_WAIT_L(0); PG8_BAR; PG8_MMA(1, 0, At, B0); PG8_MMA(1, 1, At, B1); PG8_BAR; PG8_SCHED;
            PG8_LDB(B0, 1, 0); PG8_LDB(B1, 1, 1); PG8_SCHED; PG8_LDA(At, 1, 0); PG8_STAGE(PG8_SA(0, 1), a2 + hstep, voffA);
            PG8_WAIT_V(8); PG8_WAIT_L(0); PG8_BAR; PG8_MMA(0, 0, At, B0); PG8_MMA(0, 1, At, B1); PG8_BAR; PG8_SCHED;
            PG8_LDA(At, 1, 1); PG8_STAGE(PG8_SB(1, 0), b3, voffB); PG8_STAGE(PG8_SB(1, 1), b3 + hstep, voffB); PG8_STAGE(PG8_SA(1, 0), a3, voffA);
            PG8_WAIT_V(8); PG8_WAIT_L(0); PG8_BAR; PG8_MMA(1, 0, At, B0); PG8_MMA(1, 1, At, B1); PG8_BAR; PG8_SCHED;
            } else {
            PG8_LDB(B0, 0, 0); PG8_SCHED; PG8_LDA(At, 0, 0); PG8_STAGE(PG8_SA(1, 1), a1 + hstep, voffA);
            PG8_WAIT_L(8); PG8_BAR; PG8_WAIT_L(0); PG8_MMA(0, 0, At, B0); PG8_BAR; PG8_SCHED;
            PG8_LDB(B1, 0, 1); PG8_STAGE(PG8_SB(0, 0), b2, voffB);
            PG8_BAR; PG8_WAIT_L(0); PG8_MMA(0, 1, At, B1); PG8_BAR;
            PG8_LDA(At, 0, 1); PG8_STAGE(PG8_SA(0, 0), a2, voffA);
            PG8_BAR; PG8_WAIT_L(0); PG8_MMA(1, 0, At, B0); PG8_BAR; PG8_SCHED;
            PG8_STAGE(PG8_SB(0, 1), b2 + hstep, voffB);
            PG8_WAIT_V(6); PG8_BAR; PG8_MMA(1, 1, At, B1); PG8_BAR;
            PG8_LDB(B0, 1, 0); PG8_SCHED; PG8_LDA(At, 1, 0); PG8_STAGE(PG8_SA(0, 1), a2 + hstep, voffA);
            PG8_WAIT_L(8); PG8_BAR; PG8_WAIT_L(0); PG8_MMA(0, 0, At, B0); PG8_BAR; PG8_SCHED;
            PG8_LDB(B1, 1, 1); PG8_STAGE(PG8_SB(1, 0), b3, voffB);
            PG8_BAR; PG8_WAIT_L(0); PG8_MMA(0, 1, At, B1); PG8_BAR;
            PG8_LDA(At, 1, 1); PG8_STAGE(PG8_SA(1, 0), a3, voffA);
            PG8_BAR; PG8_WAIT_L(0); PG8_MMA(1, 0, At, B0); PG8_BAR; PG8_SCHED;
            PG8_STAGE(PG8_SB(1, 1), b3 + hstep, voffB);
            PG8_WAIT_V(6); PG8_BAR; PG8_MMA(1, 1, At, B1); PG8_BAR;
            }
        }
        if constexpr (ALIGN_EPI) { if (wr == 0) PG8_BAR; }
        if constexpr (!Epi::AFTER_DRAIN) { E(acc, cur, wr, wc, fr, fq); S.done(cur); }
        if (!has_next) break;
#pragma unroll
        for (int a = 0; a < 2; ++a)
#pragma unroll
            for (int b = 0; b < 2; ++b)
#pragma unroll
                for (int m = 0; m < 4; ++m)
#pragma unroll
                    for (int n = 0; n < 2; ++n) acc[a][b][m][n] = (f32x4){0.f, 0.f, 0.f, 0.f};
        cur = nxt; cA = nA; cB = nB; ++ui;
        if constexpr (ALIGN_EPI) { if (wr == 1) PG8_BAR; }
    }
    PG8_WAIT_V(0);
    if constexpr (!ALIGN_EPI) { if (wr == 0) PG8_BAR; }
    PG8_BAR;
    if constexpr (Epi::AFTER_DRAIN) { E.fused(acc, cur, wr, wc, fr, fq, lds, wid, lane); S.done(cur); }
#undef PG8_SA
#undef PG8_SB
#undef PG8_STAGE
#undef PG8_LDA
#undef PG8_LDB
#undef PG8_MMA
#undef PG8_WAIT_V
#undef PG8_WAIT_L
#undef PG8_BAR
#undef PG8_SCHED
}
}

using pg8::bf16_t; using pg8::bf16x8; using pg8::f32x4; using pg8::u32x4; using pg8::f32x16; using pg8::cvt_pk_bf16; using pg8::fsigmoid; using pg8::fsilu; using pg8::RMS_EPS;
typedef float f32x2 __attribute__((ext_vector_type(2)));
typedef unsigned u32x2 __attribute__((ext_vector_type(2)));
constexpr int T = 16384, DM = 1024, FF = 2816, PW = 3856, NPAD = 4096, NS = 32, NCH = 256  , NCHB = 128  ;
constexpr int NTHR = 512, NWAVES = 8;
constexpr int LDS_BYTES = 147456;

constexpr size_t O_YP = 0, O_YS = 16777216, O_KAP = O_YS + 32768, O_VAP = O_KAP + 2097152, O_SBP = O_VAP + 2097152, O_SCP = O_SBP + 65536,
                 O_KAS = O_SCP + 16384, O_VAS = O_KAS + 32768, O_SBS = O_VAS + 32768, O_SCS = O_SBS + 2097152, O_END = O_SCS + 524288;
constexpr size_t al256(size_t x) { return (x + 255) & ~(size_t)255; }
constexpr size_t SZ_W1GU = (size_t)5632 * 1024 * 2, SZ_W1D = (size_t)1024 * 2816 * 2, SZ_WIN = (size_t)4096 * 1024 * 2, SZ_WOUT = (size_t)1024 * 1024 * 2, SZ_WPG = SZ_WOUT, SZ_WPP = (size_t)1024 * 256 * 2;
constexpr size_t WL_W1GU = 0, WL_W1D = WL_W1GU + SZ_W1GU, WL_WIN = WL_W1D + SZ_W1D, WL_WOUT = WL_WIN + SZ_WIN, WL_W2GU = WL_WOUT + SZ_WOUT, WL_W2D = WL_W2GU + SZ_W1GU,
                 WL_WPG = WL_W2D + SZ_W1D, WL_WPP = WL_WPG + SZ_WPG, WL_SIZE = WL_WPP + SZ_WPP;
constexpr size_t WS_W = 0;
constexpr size_t WS_HB0 = al256(WS_W + 2 * WL_SIZE), WS_HB1 = WS_HB0 + (size_t)T * DM * 2;
constexpr size_t WS_ACT = WS_HB1 + (size_t)T * DM * 2;
constexpr size_t WS_QB = WS_ACT + (size_t)T * FF * 2, WS_KB = WS_QB + (size_t)T * 512 * 2, WS_VB = WS_KB + (size_t)T * 512 * 2;
constexpr size_t WS_ZF = WS_VB + (size_t)T * 512 * 2;
constexpr size_t WS_OC = WS_ZF + (size_t)T * 2560 * 4, WS_LSE = WS_OC + (size_t)3 * T * 512 * 2;
constexpr size_t WS_MIX = WS_LSE + (size_t)3 * T * 8 * 4;
constexpr size_t WS_PB = WS_MIX + (size_t)T * DM * 2;
constexpr size_t WS_UB = WS_PB + (size_t)2 * T * 256 * 2, WS_UC = WS_UB + (size_t)NCH * 32768 * 4, WS_AB = WS_UC + (size_t)NCH * 8192 * 4, WS_AC = WS_AB + (size_t)NCH * 512 * 4;
constexpr size_t WS_SSQ0 = WS_AC + (size_t)NCH * 128 * 4, WS_SSQ1 = WS_SSQ0 + (size_t)T * 16 * 4;
constexpr size_t WS_PP = WS_SSQ1 + (size_t)T * 16 * 4;
constexpr size_t WS_LB = WS_PP + (size_t)T * DM * 4;
constexpr size_t WS_HSB0 = WS_LB + 4096, WS_HSB1 = WS_HSB0 + (size_t)NS * DM * 2, WS_ACTS = WS_HSB1 + (size_t)NS * DM * 2, WS_ZS = WS_ACTS + al256((size_t)NS * FF * 2),
                 WS_MIXS = WS_ZS + (size_t)NS * NPAD * 4, WS_PSB = WS_MIXS + (size_t)NS * DM * 2, WS_SSQS0 = WS_PSB + (size_t)2 * NS * 256 * 2, WS_SSQS1 = WS_SSQS0 + (size_t)NS * 32 * 4,
                 WS_BAR = al256(WS_SSQS1 + (size_t)NS * 32 * 4), WS_BAR_BYTES = 16384, WS_FCB = WS_BAR + WS_BAR_BYTES, WS_END = WS_FCB + (size_t)T * 128 * 4;

struct Args { const float* in[28]; float* out; unsigned char* ws; };

#define LWAIT() asm volatile("s_waitcnt lgkmcnt(0)" ::: "memory")
__device__ __forceinline__ float wave_sum(float v) {
#pragma unroll
    for (int o = 1; o < 64; o <<= 1) v += __shfl_xor(v, o);
    return v;
}
__device__ __forceinline__ unsigned pk2(float lo, float hi) { return cvt_pk_bf16(lo, hi); }

__device__ __forceinline__ int map_row(int kind, int n) {
    if (kind == 1) return 256 * (n >> 7) + (n & 127);
    if (kind == 2) return 256 * (n >> 7) + (n & 127) + 128;
    if (kind == 3) return n < 3584 ? n : (n < 3600 ? 3840 + (n - 3584) : 3584 + (n - 3600));
    return n;
}
__device__ __forceinline__ void tr_item(const float* W, int K, int N, const float* gain, bf16_t* WT, int kind, float* scr, int item, int lane) {
    const int nblk = (N + 31) / 32, kb = item / nblk, nb = item % nblk, k0 = 64 * kb, n0 = 32 * nb;
    const int c = lane & 7;
    float wv[32];
    {
        const int n = n0 + (lane & 31); const bool ok = n < N;
        const float* wp = W + (size_t)(k0 + (lane >> 5)) * N + (ok ? n : 0);
#pragma unroll
        for (int i = 0; i < 32; ++i) wv[i] = wp[(size_t)(2 * i) * N];
#pragma unroll
        for (int i = 0; i < 32; ++i) scr[(2 * i + (lane >> 5)) * 33 + (lane & 31)] = ok ? wv[i] : 0.f;
    }
    f32x4 g0 = (f32x4){1.f, 1.f, 1.f, 1.f}, g1 = g0;
    if (gain) { g0 = *(const f32x4*)(gain + k0 + 8 * c); g1 = *(const f32x4*)(gain + k0 + 8 * c + 4); }
    LWAIT();
#pragma unroll
    for (int j = 0; j < 4; ++j) {
        const int nl = (lane >> 3) + 8 * j, n = n0 + nl;
        const float* s = scr + (8 * c) * 33 + nl;
        u32x4 o; o.x = pk2(s[0 * 33] * g0[0], s[1 * 33] * g0[1]); o.y = pk2(s[2 * 33] * g0[2], s[3 * 33] * g0[3]); o.z = pk2(s[4 * 33] * g1[0], s[5 * 33] * g1[1]); o.w = pk2(s[6 * 33] * g1[2], s[7 * 33] * g1[3]);
        if (n < N) *(u32x4*)(WT + (size_t)map_row(kind, n) * K + k0 + 8 * c) = o;
    }
    LWAIT();
}

__device__ __forceinline__ void sgemm_tile(const bf16_t* A, const bf16_t* Bt, int K, int n0, float* part, int wave, int lane) {
    const int c32 = lane & 31, hi = lane >> 5, nch = K >> 6;
    f32x16 acc;
#pragma unroll
    for (int i = 0; i < 16; ++i) acc[i] = 0.f;
    for (int ch0 = wave; ch0 < nch; ch0 += 3 * NWAVES) {
        bf16x8 a[3][4], b[3][4];
#pragma unroll
        for (int c = 0; c < 3; ++c) { const int ch = ch0 + c * NWAVES;
            if (ch < nch) { const bf16_t* ap = A + (size_t)c32 * K + ch * 64 + hi * 32; const bf16_t* bp = Bt + (size_t)(n0 + c32) * K + ch * 64 + hi * 32;
#pragma unroll
                for (int j = 0; j < 4; ++j) { a[c][j] = *(const bf16x8*)(ap + 8 * j); b[c][j] = *(const bf16x8*)(bp + 8 * j); } } }
#pragma unroll
        for (int c = 0; c < 3; ++c) { const int ch = ch0 + c * NWAVES;
            if (ch < nch) {
#pragma unroll
                for (int j = 0; j < 4; ++j) acc = __builtin_amdgcn_mfma_f32_32x32x16_bf16(a[c][j], b[c][j], acc, 0, 0, 0); } }
    }
#pragma unroll
    for (int rr = 0; rr < 16; ++rr) { const int row = (rr & 3) + 8 * (rr >> 2) + 4 * hi; part[(wave * 32 + row) * 33 + c32] = acc[rr]; }
}
__device__ __forceinline__ float part_sum(const float* part, int row, int col) {
    float s = 0.f;
#pragma unroll
    for (int w = 0; w < NWAVES; ++w) s += part[(w * 32 + row) * 33 + col];
    return s;
}
__device__ __forceinline__ float row_rinv32(const float* ssqs, int row) {
    const f32x4* p = (const f32x4*)(ssqs + row * 32); float s = 0.f;
#pragma unroll
    for (int i = 0; i < 8; ++i) { const f32x4 a = p[i]; s += (a[0] + a[1]) + (a[2] + a[3]); }
    return rsqrtf(s * (1.0f / 1024.0f) + RMS_EPS);
}
constexpr int PART_FLOATS = 8 * 32 * 33;

#define ATT_LOAD_QK(UNIT) do { const int cfg_ = (UNIT) >> 12, rem_ = (UNIT) & 4095, h_ = rem_ >> 9, blk_ = rem_ & 511, dsh_ = cfg_ * 2, r_ = blk_ >> (9 - dsh_), i0_ = (blk_ & ((512 >> dsh_) - 1)) * 32; \
        const int tq_ = ((i0_ + c32) << dsh_) + r_; \
        _Pragma("unroll") for (int s = 0; s < 4; ++s) qf[s] = *(const bf16x8*)(Qb + ((size_t)h_ * T + tq_) * 64 + 16 * s + 8 * hi); \
        _Pragma("unroll") for (int kt = 0; kt < 2; ++kt) { int ik = i0_ - 128 + 32 * kt + c32; ik = ik < 0 ? 0 : ik; \
            const bf16_t* kp = Kb + ((size_t)h_ * T + ((ik << dsh_) + r_)) * 64 + 8 * hi; \
            _Pragma("unroll") for (int s = 0; s < 4; ++s) kf[kt][s] = *(const bf16x8*)(kp + 16 * s); } } while (0)
__device__ __forceinline__ void attn_units(unsigned char* wsb, int unit0, int nu, unsigned char* vt, int lane) {
    const bf16_t* Qb = (const bf16_t*)(wsb + WS_QB); const bf16_t* Kb = (const bf16_t*)(wsb + WS_KB); const bf16_t* Vb = (const bf16_t*)(wsb + WS_VB);
    bf16_t* Oc = (bf16_t*)(wsb + WS_OC); float* LSE = (float*)(wsb + WS_LSE);
    const int c32 = lane & 31, hi = lane >> 5;
    bf16x8 qf[4], kf[5][4];
    if (nu > 0) ATT_LOAD_QK(unit0);
    for (int ui = 0; ui < nu; ++ui) {
        const int unit = unit0 + ui;
        const int cfg = unit >> 12, rem = unit & 4095, h = rem >> 9, blk = rem & 511;
        const int dsh = cfg * 2, dil = 1 << dsh;
        const int r = blk >> (9 - dsh), ib = blk & ((512 >> dsh) - 1), i0 = ib * 32;
        const float sl2 = exp2f(-(float)(h + 1)) * (float)dil * 1.4426950408889634f;
        const int tq = ((i0 + c32) << dsh) + r;
        float brr[16];
#pragma unroll
        for (int rr = 0; rr < 16; ++rr) brr[rr] = sl2 * (float)((rr & 3) + 8 * (rr >> 2) + 4 * hi);
#pragma unroll
        for (int kt = 2; kt < 5; ++kt) { int ik = i0 - 128 + 32 * kt + c32; ik = ik < 0 ? 0 : ik;
            const bf16_t* kp = Kb + ((size_t)h * T + ((ik << dsh) + r)) * 64 + 8 * hi;
#pragma unroll
            for (int s = 0; s < 4; ++s) kf[kt][s] = *(const bf16x8*)(kp + 16 * s); }
        f32x16 st[5];
#pragma unroll
        for (int kt = 0; kt < 5; ++kt) {
            const float base = -sl2 * (float)(128 + c32 - 32 * kt);
            f32x16 a;
#pragma unroll
            for (int i = 0; i < 16; ++i) a[i] = base + brr[i];
#pragma unroll
            for (int s = 0; s < 4; ++s) a = __builtin_amdgcn_mfma_f32_32x32x16_bf16(kf[kt][s], qf[s], a, 0, 0, 0);
            st[kt] = a;
        }
        u32x4 vreg[3][4];
#pragma unroll
        for (int kt = 0; kt < 3; ++kt)
#pragma unroll
            for (int cc = 0; cc < 4; ++cc) {
                const int chunk = lane + 64 * cc, key = chunk >> 3, part = chunk & 7;
                int ik = i0 - 128 + 32 * kt + key; ik = ik < 0 ? 0 : ik;
                vreg[kt][cc] = *(const u32x4*)(Vb + ((size_t)h * T + ((ik << dsh) + r)) * 64 + part * 8);
            }
#pragma unroll
        for (int rr = 0; rr < 16; ++rr) {
            const int kk = (rr & 3) + 8 * (rr >> 2) + 4 * hi;
            st[0][rr] = (kk >= c32) ? st[0][rr] : -1e30f;
            st[4][rr] = (kk <= c32) ? st[4][rr] : -1e30f;
        }
        if (i0 < 128) {
#pragma unroll
            for (int kt = 0; kt < 4; ++kt)
#pragma unroll
                for (int rr = 0; rr < 16; ++rr) { const int kk = (rr & 3) + 8 * (rr >> 2) + 4 * hi; st[kt][rr] = (i0 - 128 + 32 * kt + kk >= 0) ? st[kt][rr] : -1e30f; }
        }
        float mx = -1e30f;
#pragma unroll
        for (int kt = 0; kt < 5; ++kt)
#pragma unroll
            for (int rr = 0; rr < 16; ++rr) mx = fmaxf(mx, st[kt][rr]);
        mx = fmaxf(mx, __shfl_xor(mx, 32));
        float den = 0.f;
        bf16x8 pf[5][2];
#pragma unroll
        for (int kt = 0; kt < 5; ++kt)
#pragma unroll
            for (int s2 = 0; s2 < 2; ++s2) {
                float p[8];
#pragma unroll
                for (int j = 0; j < 8; ++j) { p[j] = __builtin_amdgcn_exp2f(st[kt][8 * s2 + j] - mx); den += p[j]; }
                u32x4 w; w.x = cvt_pk_bf16(p[0], p[1]); w.y = cvt_pk_bf16(p[2], p[3]); w.z = cvt_pk_bf16(p[4], p[5]); w.w = cvt_pk_bf16(p[6], p[7]);
                pf[kt][s2] = __builtin_bit_cast(bf16x8, w);
            }
        den += __shfl_xor(den, 32);
        if (ui + 1 < nu) ATT_LOAD_QK(unit + 1);
        f32x16 o0, o1;
#pragma unroll
        for (int i = 0; i < 16; ++i) { o0[i] = 0.f; o1[i] = 0.f; }
#pragma unroll
        for (int kt = 0; kt < 5; ++kt) {
#pragma unroll
            for (int cc = 0; cc < 4; ++cc) {
                const int chunk = lane + 64 * cc, key = chunk >> 3, part = chunk & 7;
                *(u32x4*)(vt + key * 144 + part * 16) = vreg[kt % 3][cc];
            }
            if (kt < 2) {
#pragma unroll
                for (int cc = 0; cc < 4; ++cc) {
                    const int chunk = lane + 64 * cc, key = chunk >> 3, part = chunk & 7;
                    int ik = i0 - 128 + 32 * (kt + 3) + key; ik = ik < 0 ? 0 : ik;
                    vreg[kt][cc] = *(const u32x4*)(Vb + ((size_t)h * T + ((ik << dsh) + r)) * 64 + part * 8);
                }
            }
            LWAIT();
#pragma unroll
            for (int s2 = 0; s2 < 2; ++s2) {
#pragma unroll
                for (int dh = 0; dh < 2; ++dh) {
                    typedef short v4i16_t __attribute__((ext_vector_type(4)));
                    const int trow = (lane >> 2) & 3, tcol = 16 * ((lane >> 4) & 1) + 4 * (lane & 3) + 32 * dh;
                    const v4i16_t lo4 = __builtin_amdgcn_ds_read_tr16_b64_v4i16((__attribute__((address_space(3))) v4i16_t*)(vt + (16 * s2 + 4 * hi + trow) * 144 + tcol * 2));
                    const v4i16_t hi4 = __builtin_amdgcn_ds_read_tr16_b64_v4i16((__attribute__((address_space(3))) v4i16_t*)(vt + (16 * s2 + 8 + 4 * hi + trow) * 144 + tcol * 2));
                    bf16x8 vf; vf[0] = lo4[0]; vf[1] = lo4[1]; vf[2] = lo4[2]; vf[3] = lo4[3]; vf[4] = hi4[0]; vf[5] = hi4[1]; vf[6] = hi4[2]; vf[7] = hi4[3];
                    if (dh == 0) o0 = __builtin_amdgcn_mfma_f32_32x32x16_bf16(vf, pf[kt][s2], o0, 0, 0, 0);
                    else         o1 = __builtin_amdgcn_mfma_f32_32x32x16_bf16(vf, pf[kt][s2], o1, 0, 0, 0);
                }
            }
            LWAIT();
        }
        const float inv = 1.0f / den;
        bf16_t* op = Oc + ((size_t)cfg * T + tq) * 512 + h * 64 + 4 * hi;
#pragma unroll
        for (int g = 0; g < 4; ++g) {
            u32x2 w0, w1;
            w0.x = cvt_pk_bf16(o0[4 * g] * inv, o0[4 * g + 1] * inv); w0.y = cvt_pk_bf16(o0[4 * g + 2] * inv, o0[4 * g + 3] * inv);
            w1.x = cvt_pk_bf16(o1[4 * g] * inv, o1[4 * g + 1] * inv); w1.y = cvt_pk_bf16(o1[4 * g + 2] * inv, o1[4 * g + 3] * inv);
            *(u32x2*)(op + 8 * g) = w0; *(u32x2*)(op + 32 + 8 * g) = w1;
        }
        if (hi == 0) LSE[((size_t)cfg * T + tq) * 8 + h] = (mx + __builtin_amdgcn_logf(den)) * 0.6931471805599453f;
    }
}

#define LO2(v) (__builtin_shufflevector((v), (v), 0, 1))
#define HI2(v) (__builtin_shufflevector((v), (v), 2, 3))
__device__ __forceinline__ f32x4 fgate4(f32x4 z, f32x4 lbv) { f32x4 o;
#pragma unroll
    for (int j = 0; j < 4; ++j) o[j] = lbv[j] + (1.0f - lbv[j]) * fsigmoid(z[j]);
    return o; }
__device__ __forceinline__ f32x4 silu4(f32x4 z) { f32x4 o;
#pragma unroll
    for (int j = 0; j < 4; ++j) o[j] = fsilu(z[j]);
    return o; }
__device__ __forceinline__ void b_local(const float* ZF, const float* lb, float* UB, float* AB, int n, int h, unsigned char* smem, int tid, int wave, int lane) {
    float* fL = (float*)smem; float* vL = fL + 128 * 128;
    const int t0 = 128 * n;
    {
        f32x4 rf[8], rv[4];
        const f32x4 lbv = *(const f32x4*)(lb + h * 128 + 4 * (tid & 31));
#pragma unroll
        for (int i = 0; i < 8; ++i) { const int idx = tid + NTHR * i, t = idx >> 5, k4 = idx & 31; rf[i] = *(const f32x4*)(ZF + (size_t)(t0 + t) * 2560 + 512 + h * 128 + 4 * k4); }
#pragma unroll
        for (int i = 0; i < 4; ++i) { const int idx = tid + NTHR * i, t = idx >> 4, v4 = idx & 15; rv[i] = *(const f32x4*)(ZF + (size_t)(t0 + t) * 2560 + 1024 + h * 64 + 4 * v4); }
#pragma unroll
        for (int i = 0; i < 8; ++i) { const int idx = tid + NTHR * i, t = idx >> 5, k4 = idx & 31; *(f32x4*)(fL + t * 128 + 4 * k4) = fgate4(rf[i], lbv); }
#pragma unroll
        for (int i = 0; i < 4; ++i) { const int idx = tid + NTHR * i, t = idx >> 4, v4 = idx & 15; *(f32x4*)(vL + t * 64 + 4 * v4) = rv[i]; }
    }
    __syncthreads();
    f32x2 S[8];
#pragma unroll
    for (int k = 0; k < 8; ++k) S[k] = (f32x2){0.f, 0.f};
    {
        f32x4 fc[4]; float vc = vL[lane];
#pragma unroll
        for (int q4 = 0; q4 < 4; ++q4) fc[q4] = *(const f32x4*)(fL + 16 * wave + 4 * q4);
#pragma unroll 2
        for (int t = 0; t < 128; ++t) {
            const int tn = (t + 1) & 127;
            f32x4 fn[4]; const float vn = vL[tn * 64 + lane];
#pragma unroll
            for (int q4 = 0; q4 < 4; ++q4) fn[q4] = *(const f32x4*)(fL + tn * 128 + 16 * wave + 4 * q4);
            const f32x2 vc2 = (f32x2){vc, vc};
#pragma unroll
            for (int q4 = 0; q4 < 4; ++q4) { S[2 * q4] = LO2(fc[q4]) * (S[2 * q4] - vc2) + vc2; S[2 * q4 + 1] = HI2(fc[q4]) * (S[2 * q4 + 1] - vc2) + vc2; }
#pragma unroll
            for (int q4 = 0; q4 < 4; ++q4) fc[q4] = fn[q4];
            vc = vn;
        }
    }
    float* up = UB + ((size_t)(n * 4 + h) * 128 + 16 * wave) * 64 + lane;
#pragma unroll
    for (int k = 0; k < 8; ++k) { up[(2 * k) * 64] = S[k][0]; up[(2 * k + 1) * 64] = S[k][1]; }
    { float ap = 1.f; const int kq = lane & 15, pt = lane >> 4;
#pragma unroll
      for (int t = 0; t < 32; ++t) ap *= fL[(32 * pt + t) * 128 + 16 * wave + kq];
      ap *= __shfl_xor(ap, 16); ap *= __shfl_xor(ap, 32);
      if (lane < 16) AB[(size_t)(n * 4 + h) * 128 + 16 * wave + lane] = ap; }
    __syncthreads();
}
__device__ __forceinline__ void b_output(const float* ZF, const float* lb, const float* S0B, const float* bnorm, bf16_t* mixed, int n, int h, unsigned char* smem, int tid, int wave, int lane) {
    float* fL = (float*)smem; float* qL = fL + 32 * 128; float* vL = qL + 32 * 128; float* oP = vL + 32 * 64;
    f32x2 S[8];
    { const float* sp = S0B + ((size_t)(n * 4 + h) * 128 + 16 * wave) * 64 + lane;
#pragma unroll
      for (int k = 0; k < 8; ++k) { S[k][0] = sp[(2 * k) * 64]; S[k][1] = sp[(2 * k + 1) * 64]; } }
    const int lt = tid >> 5, lk4 = tid & 31;
    const int rt = tid >> 4, rv4 = tid & 15;
    const f32x4 lbv = *(const f32x4*)(lb + h * 128 + 4 * lk4);
    const f32x4 bn = *(const f32x4*)(bnorm + h * 64 + 4 * rv4);
    f32x4 rf[2], rq[2], rv;
    { const int t0 = 128 * n;
#pragma unroll
      for (int i = 0; i < 2; ++i) { const float* zr = ZF + (size_t)(t0 + lt + 16 * i) * 2560 + h * 128 + 4 * lk4; rf[i] = *(const f32x4*)(zr + 512); rq[i] = *(const f32x4*)zr; }
      rv = *(const f32x4*)(ZF + (size_t)(t0 + rt) * 2560 + 1024 + h * 64 + 4 * rv4); }
    for (int sc = 0; sc < 4; ++sc) {
        const int t0 = 128 * n + 32 * sc;
#pragma unroll
        for (int i = 0; i < 2; ++i) { *(f32x4*)(fL + (lt + 16 * i) * 128 + 4 * lk4) = fgate4(rf[i], lbv); *(f32x4*)(qL + (lt + 16 * i) * 128 + 4 * lk4) = silu4(rq[i]); }
        *(f32x4*)(vL + rt * 64 + 4 * rv4) = rv;
        const f32x4 g = *(const f32x4*)(ZF + (size_t)(t0 + rt) * 2560 + 1280 + h * 64 + 4 * rv4);
        __syncthreads();
        if (sc < 3) {
#pragma unroll
            for (int i = 0; i < 2; ++i) { const float* zr = ZF + (size_t)(t0 + 32 + lt + 16 * i) * 2560 + h * 128 + 4 * lk4; rf[i] = *(const f32x4*)(zr + 512); rq[i] = *(const f32x4*)zr; }
            rv = *(const f32x4*)(ZF + (size_t)(t0 + 32 + rt) * 2560 + 1024 + h * 64 + 4 * rv4);
        }
        {
            f32x4 fc[4], qc[4]; float vc = vL[lane];
#pragma unroll
            for (int q4 = 0; q4 < 4; ++q4) { fc[q4] = *(const f32x4*)(fL + 16 * wave + 4 * q4); qc[q4] = *(const f32x4*)(qL + 16 * wave + 4 * q4); }
#pragma unroll 2
            for (int t = 0; t < 32; ++t) {
                const int tn = (t + 1) & 31;
                f32x4 fn[4], qn[4]; const float vn = vL[tn * 64 + lane];
#pragma unroll
                for (int q4 = 0; q4 < 4; ++q4) { fn[q4] = *(const f32x4*)(fL + tn * 128 + 16 * wave + 4 * q4); qn[q4] = *(const f32x4*)(qL + tn * 128 + 16 * wave + 4 * q4); }
                const f32x2 vc2 = (f32x2){vc, vc}; f32x2 oa = (f32x2){0.f, 0.f}, ob = oa;
#pragma unroll
                for (int q4 = 0; q4 < 4; ++q4) {
                    const f32x2 s0 = LO2(fc[q4]) * (S[2 * q4] - vc2) + vc2, s1 = HI2(fc[q4]) * (S[2 * q4 + 1] - vc2) + vc2;
                    S[2 * q4] = s0; S[2 * q4 + 1] = s1; oa += LO2(qc[q4]) * s0; ob += HI2(qc[q4]) * s1;
                }
                oa += ob;
                oP[(wave * 32 + t) * 64 + lane] = oa[0] + oa[1];
#pragma unroll
                for (int q4 = 0; q4 < 4; ++q4) { fc[q4] = fn[q4]; qc[q4] = qn[q4]; }
                vc = vn;
            }
        }
        __syncthreads();
        { f32x4 o = (f32x4){0.f, 0.f, 0.f, 0.f};
#pragma unroll
          for (int w = 0; w < 8; ++w) o += *(const f32x4*)(oP + (w * 32 + rt) * 64 + 4 * rv4);
          float ss = (o[0] * o[0] + o[1] * o[1]) + (o[2] * o[2] + o[3] * o[3]);
#pragma unroll
          for (int d = 1; d < 16; d <<= 1) ss += __shfl_xor(ss, d);
          const float rinv = rsqrtf(ss * (1.0f / 64.0f) + RMS_EPS);
          u32x2 w2; w2.x = cvt_pk_bf16(o[0] * rinv * bn[0] * fsigmoid(g[0]), o[1] * rinv * bn[1] * fsigmoid(g[1])); w2.y = cvt_pk_bf16(o[2] * rinv * bn[2] * fsigmoid(g[2]), o[3] * rinv * bn[3] * fsigmoid(g[3]));
          *(u32x2*)(mixed + (size_t)(t0 + rt) * 1024 + 512 + h * 64 + 4 * rv4) = w2; }
    }
    __syncthreads();
}

__device__ __forceinline__ float logsig16_exp(float x) {
    const float ls = fminf(x, 0.f) - __logf(1.0f + __expf(-fabsf(x)));
    return __expf(ls * 0.0625f);
}
template <bool OUT>
__device__ __forceinline__ void c_task(const float* ZF, float* FCB, const float* cwg, const float* cbias, float* UC, float* AC, const float* cnorm, bf16_t* mixed,
                                       int n, int h, float* wl  , int lane) {
    float* fcL = wl; float* kcL = wl + 512; float* qcL = wl + 1024; float* vL = wl + 1536; float* gL = wl + 2560;
    const int k = lane & 31, th = lane >> 5;
    float cw[16];
#pragma unroll
    for (int r = 0; r < 16; ++r) cw[r] = OUT ? 0.f : cwg[r * 128 + h * 32 + k];
    const float cb = OUT ? 0.f : cbias[h * 32 + k];
    const float cn = OUT ? cnorm[h * 64 + lane] : 0.f;
    f32x2 S[16];
    float* ucp = UC + ((size_t)(n * 4 + h) * 32) * 64 + lane;
#pragma unroll
    for (int kk = 0; kk < 16; ++kk) { S[kk][0] = OUT ? ucp[(2 * kk) * 64] : 0.f; S[kk][1] = OUT ? ucp[(2 * kk + 1) * 64] : 0.f; }
    float ap = 1.f;
#pragma unroll 1
    for (int sc = 0; sc < 4; ++sc) {
        const int t0 = 64 * n + 16 * sc;
        {
            float rk[8], rq[8], rfc[8], rvv[16], rgg[16]; f32x4 rclr = (f32x4){0.f, 0.f, 0.f, 0.f};
#pragma unroll
            for (int i = 0; i < 8; ++i) { const int t = 2 * i + th; const float* zr = ZF + (size_t)(t0 + t) * 2560;
                rk[i] = zr[1664 + h * 32 + k]; rq[i] = OUT ? zr[1536 + h * 32 + k] : 0.f; rfc[i] = OUT ? FCB[(size_t)(t0 + t) * 128 + h * 32 + k] : 0.f; }
#pragma unroll
            for (int t = 0; t < 16; ++t) { rvv[t] = ZF[(size_t)(t0 + t) * 2560 + 1792 + h * 64 + lane]; rgg[t] = OUT ? ZF[(size_t)(t0 + t) * 2560 + 2048 + h * 64 + lane] : 0.f; }
            if (!OUT) rclr = *(const f32x4*)(ZF + (size_t)(t0 + (lane >> 2)) * 2560 + 2304 + 4 * (lane & 3));
#pragma unroll
            for (int i = 0; i < 8; ++i) { const int t = 2 * i + th; kcL[t * 32 + k] = rk[i]; if (OUT) { qcL[t * 32 + k] = rq[i] * 0.17677669529663687f; fcL[t * 32 + k] = rfc[i]; } }
#pragma unroll
            for (int t = 0; t < 16; ++t) { vL[t * 64 + lane] = rvv[t]; if (OUT) gL[t * 64 + lane] = fsilu(rgg[t]); }
            if (!OUT) {
                *(f32x4*)(gL + 4 * lane) = rclr;
                LWAIT();
#pragma unroll 2
                for (int i = 0; i < 8; ++i) { const int t = 2 * i + th;
                    float x = cb;
#pragma unroll
                    for (int r4 = 0; r4 < 4; ++r4) { const f32x4 c4 = *(const f32x4*)(gL + t * 16 + 4 * r4); x += c4[0] * cw[4 * r4] + c4[1] * cw[4 * r4 + 1] + c4[2] * cw[4 * r4 + 2] + c4[3] * cw[4 * r4 + 3]; }
                    const float fv = logsig16_exp(x);
                    fcL[t * 32 + k] = fv; FCB[(size_t)(t0 + t) * 128 + h * 32 + k] = fv; }
            }
        }
        LWAIT();
        if (!OUT) {
#pragma unroll 4
            for (int t = 0; t < 16; ++t) ap *= fcL[t * 32 + k];
        }
        {
            f32x4 fcu[4], kcu[4], qcu[4];
#pragma unroll
            for (int j = 0; j < 4; ++j) { fcu[j] = *(const f32x4*)(fcL + 4 * j); kcu[j] = *(const f32x4*)(kcL + 4 * j); qcu[j] = OUT ? *(const f32x4*)(qcL + 4 * j) : (f32x4){0.f, 0.f, 0.f, 0.f}; }
            float vv = vL[lane]; f32x2 o2 = (f32x2){0.f, 0.f};
#pragma unroll 2
            for (int u = 0; u < 32; ++u) {
                const int half = u & 1, t = u >> 1, un = (u + 1) & 31, tn = un >> 1, hn = un & 1;
                f32x4 fnu[4], knu[4], qnu[4];
#pragma unroll
                for (int j = 0; j < 4; ++j) { fnu[j] = *(const f32x4*)(fcL + tn * 32 + 16 * hn + 4 * j); knu[j] = *(const f32x4*)(kcL + tn * 32 + 16 * hn + 4 * j); qnu[j] = OUT ? *(const f32x4*)(qcL + tn * 32 + 16 * hn + 4 * j) : (f32x4){0.f, 0.f, 0.f, 0.f}; }
                const float vnx = vL[tn * 64 + lane];
                const f32x2 vv2 = (f32x2){vv, vv};
#pragma unroll
                for (int j = 0; j < 4; ++j) {
                    if (half == 0) { const f32x2 s0 = LO2(fcu[j]) * S[2 * j] + LO2(kcu[j]) * vv2, s1 = HI2(fcu[j]) * S[2 * j + 1] + HI2(kcu[j]) * vv2; S[2 * j] = s0; S[2 * j + 1] = s1; if (OUT) { o2 += LO2(qcu[j]) * s0; o2 += HI2(qcu[j]) * s1; } }
                    else           { const f32x2 s0 = LO2(fcu[j]) * S[8 + 2 * j] + LO2(kcu[j]) * vv2, s1 = HI2(fcu[j]) * S[8 + 2 * j + 1] + HI2(kcu[j]) * vv2; S[8 + 2 * j] = s0; S[8 + 2 * j + 1] = s1; if (OUT) { o2 += LO2(qcu[j]) * s0; o2 += HI2(qcu[j]) * s1; } }
                }
                if (half == 1) { if (OUT) vL[t * 64 + lane] = o2[0] + o2[1]; o2 = (f32x2){0.f, 0.f}; vv = vnx; }
#pragma unroll
                for (int j = 0; j < 4; ++j) { fcu[j] = fnu[j]; kcu[j] = knu[j]; qcu[j] = qnu[j]; }
            }
        }
        LWAIT();
        if (OUT) {
            { const int t = lane >> 2, part = lane & 3; float ss = 0.f;
#pragma unroll
              for (int i = 0; i < 4; ++i) { const f32x4 x = *(const f32x4*)(vL + t * 64 + part * 16 + 4 * i); ss += (x[0] * x[0] + x[1] * x[1]) + (x[2] * x[2] + x[3] * x[3]); }
              ss += __shfl_xor(ss, 1); ss += __shfl_xor(ss, 2);
              if (part == 0) fcL[t] = rsqrtf(ss * (1.0f / 64.0f) + RMS_EPS); }
            LWAIT();
#pragma unroll 4
            for (int t = 0; t < 16; ++t) {
                const float y = vL[t * 64 + lane] * fcL[t] * cn * gL[t * 64 + lane];
                mixed[(size_t)(t0 + t) * 1024 + 768 + h * 64 + lane] = (bf16_t)(cvt_pk_bf16(y, 0.f) & 0xffffu);
            }
            LWAIT();
        }
    }
    if (!OUT) {
#pragma unroll
        for (int kk = 0; kk < 16; ++kk) { ucp[(2 * kk) * 64] = S[kk][0]; ucp[(2 * kk + 1) * 64] = S[kk][1]; }
        if (lane < 32) AC[(size_t)(n * 4 + h) * 32 + k] = ap;
    }
}

__device__ __forceinline__ void s_attn(const float* zs, const float* ck, const float* cv  , bf16_t* mixs, float* kas, float* vas,
                                       int b, int h, unsigned char* smem, int tid, int wave, int lane) {
    float* sc = (float*)smem;
    float* pr = sc + 400;
    float* po = pr + 400;
    const float* zr = zs + (size_t)b * NPAD;
    const float slope = exp2f(-(float)(h + 1));
    if (tid < 387) {
        const int cfg = tid / 129, j = tid % 129, dil = 1 << (2 * cfg);
        const float* kr = (j == 0) ? (zr + 512 + h * 64) : (ck + ((size_t)b * 2048 + (2048 - j * dil)) * 512 + h * 64);
        float d = 0.f;
#pragma unroll
        for (int i = 0; i < 16; ++i) { const f32x4 kv = *(const f32x4*)(kr + 4 * i), qv = *(const f32x4*)(zr + h * 64 + 4 * i); d += kv[0] * qv[0] + kv[1] * qv[1] + kv[2] * qv[2] + kv[3] * qv[3]; }
        sc[tid] = d * 0.125f - slope * (float)(j * dil);
        ((int*)(po + 512))[tid] = (j == 0) ? -1 : (2048 - j * dil);
    }
    __syncthreads();
    float mx = -1e30f;
    for (int i = lane; i < 387; i += 64) mx = fmaxf(mx, sc[i]);
#pragma unroll
    for (int o = 1; o < 64; o <<= 1) mx = fmaxf(mx, __shfl_xor(mx, o));
    float den = 0.f;
    for (int i = lane; i < 387; i += 64) den += __expf(sc[i] - mx);
    den = wave_sum(den);
    if (tid < 387) pr[tid] = __expf(sc[tid] - mx) / den;
    __syncthreads();
    {
        const int d4 = tid & 15, part = tid >> 4;
        const int* ro = (const int*)(po + 512);
        const float* vnew = zr + 1024 + h * 64; const float* vbase = cv + (size_t)b * 2048 * 512 + h * 64;
        f32x4 vrow[13]; float pw[13];
#pragma unroll
        for (int j = 0; j < 13; ++j) { const int i = part + 32 * j; const bool ok = i < 387; const int rr = ok ? ro[i] : -1;
            const float* vr = (rr < 0) ? vnew : (vbase + (size_t)rr * 512);
            vrow[j] = *(const f32x4*)(vr + 4 * d4); pw[j] = ok ? pr[i] : 0.f; }
        f32x4 a = (f32x4){0.f, 0.f, 0.f, 0.f};
#pragma unroll
        for (int j = 0; j < 13; ++j) a += vrow[j] * pw[j];
        float* pp2 = po + 1024;
        *(f32x4*)(pp2 + part * 64 + 4 * d4) = a;
    }
    __syncthreads();
    if (tid < 64) { float o = 0.f;
#pragma unroll
        for (int p = 0; p < 32; ++p) o += po[1024 + p * 64 + tid];
        po[tid] = o; }
    __syncthreads();
    if (tid < 64) {
        const float o = po[tid];
        mixs[(size_t)b * 1024 + h * 64 + tid] = (bf16_t)(cvt_pk_bf16(o, 0.f) & 0xffffu);
        kas[(size_t)b * 512 + h * 64 + tid] = zr[512 + h * 64 + tid];
        vas[(size_t)b * 512 + h * 64 + tid] = zr[1024 + h * 64 + tid];
    }
    __syncthreads();
}
__device__ __forceinline__ void s_b(const float* zs, const float* sb0  , float* sbo  , const float* lb, const float* bnorm, bf16_t* mixs,
                                    int b, int h, unsigned char* smem, int tid, int wave, int lane) {
    float* po = (float*)smem;
    const float* zr = zs + (size_t)b * NPAD;
    const float vv = zr[2560 + h * 64 + lane];
    float op = 0.f;
    {
        float s0v[16], zf[16], zq[16], lbk[16];
#pragma unroll
        for (int kk = 0; kk < 16; ++kk) { const int k = 16 * wave + kk; s0v[kk] = sb0[(((size_t)b * 4 + h) * 128 + k) * 64 + lane]; zf[kk] = zr[2048 + h * 128 + k]; zq[kk] = zr[1536 + h * 128 + k]; lbk[kk] = lb[h * 128 + k]; }
#pragma unroll
        for (int kk = 0; kk < 16; ++kk) { const int k = 16 * wave + kk;
            const float f = lbk[kk] + (1.0f - lbk[kk]) * (1.0f / (1.0f + __expf(-zf[kk])));
            const float s1 = f * s0v[kk] + (1.0f - f) * vv;
            sbo[(((size_t)b * 4 + h) * 128 + k) * 64 + lane] = s1;
            op += fsilu(zq[kk]) * s1; }
    }
    po[wave * 64 + lane] = op;
    __syncthreads();
    if (tid < 64) {
        float o = 0.f;
#pragma unroll
        for (int w = 0; w < 8; ++w) o += po[w * 64 + tid];
        const float ss = wave_sum(o * o);
        const float y = o * rsqrtf(ss * (1.0f / 64.0f) + RMS_EPS) * bnorm[h * 64 + tid] * fsigmoid(zr[2816 + h * 64 + tid]);
        mixs[(size_t)b * 1024 + 512 + h * 64 + tid] = (bf16_t)(cvt_pk_bf16(y, 0.f) & 0xffffu);
    }
    __syncthreads();
}
__device__ __forceinline__ void s_c(const float* zs, const float* sc0  , float* sco, const float* cwg, const float* cbias, const float* cnorm, bf16_t* mixs,
                                    int b, int h, unsigned char* smem, int tid, int wave, int lane) {
    float* po = (float*)smem;
    const float* zr = zs + (size_t)b * NPAD;
    const float vv = zr[3328 + h * 64 + lane];
    float op = 0.f;
#pragma unroll
    for (int kk = 0; kk < 4; ++kk) {
        const int k = 4 * wave + kk;
        float x = cbias[h * 32 + k];
#pragma unroll
        for (int r = 0; r < 16; ++r) x += zr[3840 + r] * cwg[r * 128 + h * 32 + k];
        const float f = logsig16_exp(x);
        const size_t si = (((size_t)b * 4 + h) * 32 + k) * 64 + lane;
        const float s1 = f * sc0[si] + zr[3200 + h * 32 + k] * vv;
        sco[si] = s1;
        op += zr[3072 + h * 32 + k] * 0.17677669529663687f * s1;
    }
    po[wave * 64 + lane] = op;
    __syncthreads();
    if (tid < 64) {
        float o = 0.f;
#pragma unroll
        for (int w = 0; w < 8; ++w) o += po[w * 64 + tid];
        const float ss = wave_sum(o * o);
        const float y = o * rsqrtf(ss * (1.0f / 64.0f) + RMS_EPS) * cnorm[h * 64 + tid] * fsilu(zr[3584 + h * 64 + tid]);
        mixs[(size_t)b * 1024 + 768 + h * 64 + tid] = (bf16_t)(cvt_pk_bf16(y, 0.f) & 0xffffu);
    }
    __syncthreads();
}

#define LAS __attribute__((address_space(3)))
#define XB_TMO      128
#define XB_XCNT(j)  (256  + 64 * (j))
#define XB_XSUB(j)  (1280 + 64 * (j))
#define XB_XGEN(j)  (2304 + 64 * (j))
#define XB_TOP      3328
#define XB_TOPGEN   3392
#define XCD_BAR_WORDS 3456
#define XB_SPIN_CAP (1u << 18)

__device__ __forceinline__ unsigned xb_ld(unsigned* p)              { return __hip_atomic_load(p, __ATOMIC_RELAXED, __HIP_MEMORY_SCOPE_AGENT); }
__device__ __forceinline__ unsigned xb_add(unsigned* p, unsigned v) { return __hip_atomic_fetch_add(p, v, __ATOMIC_RELAXED, __HIP_MEMORY_SCOPE_AGENT); }
__device__ __forceinline__ unsigned xb_xcc_id() { return (unsigned)__builtin_amdgcn_s_getreg((3 << 11) | 20) & 0xFu; }
#define XB_SPIN(cond, bar) do { unsigned _sp = 0; while (cond) { __builtin_amdgcn_s_sleep(1); \
    if ((++_sp & 255u) == 0u) { if (xb_ld(&(bar)[XB_TMO])) break; if (_sp > XB_SPIN_CAP) { atomicAdd(&(bar)[XB_TMO], 1u); break; } } } } while (0)

struct XcdBarrier {
    unsigned* bar; unsigned x;
    volatile LAS unsigned* st;
};

__device__ __forceinline__ XcdBarrier xcd_barrier_post(unsigned* bar, volatile LAS unsigned* st, bool is_t0) {
    XcdBarrier b; b.bar = bar; b.x = xb_xcc_id(); b.st = st;
    if (is_t0) (void)xb_add(&bar[XB_XCNT(b.x)], 1u);
    return b;
}
__device__ __forceinline__ void xcd_barrier_complete(unsigned* bar, unsigned x, unsigned& nloc, unsigned& nx) {
    const unsigned G = gridDim.x * gridDim.y * gridDim.z;
    unsigned sum, cnt, mine, sp = 0u;
    for (;;) {
        sum = 0u; cnt = 0u; mine = 0u;
#pragma unroll
        for (unsigned j = 0; j < 16; ++j) { const unsigned c = xb_ld(&bar[XB_XCNT(j)]); sum += c; cnt += (c > 0u) ? 1u : 0u; mine = (j == x) ? c : mine; }
        if (sum == G) break;
        __builtin_amdgcn_s_sleep(1);
        if ((++sp & 255u) == 0u) { if (xb_ld(&bar[XB_TMO])) break; if (sp > XB_SPIN_CAP) { atomicAdd(&bar[XB_TMO], 1u); break; } }
    }
    nloc = mine > 0u ? mine : 1u; nx = cnt > 0u ? cnt : 1u;
}

__device__ __forceinline__ void xcd_barrier(const XcdBarrier& b, bool is_t0) {
    asm volatile("s_waitcnt vmcnt(0)" ::: "memory");
    __syncthreads();
    if (is_t0) {
        unsigned* bar = b.bar;
        __builtin_amdgcn_s_waitcnt(0);
        unsigned nloc = b.st[0], nx = b.st[1];
        if (nloc == 0u) { xcd_barrier_complete(bar, b.x, nloc, nx); b.st[0] = nloc; b.st[1] = nx; }
        const unsigned old = xb_add(&bar[XB_XSUB(b.x)], 1u);
        const unsigned gen = old / nloc;
        if (old + 1u == (gen + 1u) * nloc) {
            __builtin_amdgcn_fence(__ATOMIC_RELEASE, "agent");
            asm volatile("s_waitcnt vmcnt(0)" ::: "memory");
            const unsigned og = xb_add(&bar[XB_TOP], 1u);
            const unsigned tg = og / nx;
            if (og + 1u == (tg + 1u) * nx) xb_add(&bar[XB_TOPGEN], 1u);
            else XB_SPIN(xb_ld(&bar[XB_TOPGEN]) == tg, bar);
            __builtin_amdgcn_fence(__ATOMIC_ACQUIRE, "agent");
            xb_add(&bar[XB_XGEN(b.x)], 1u);
            asm volatile("s_waitcnt vmcnt(0)" ::: "memory");
        } else {
            XB_SPIN(xb_ld(&bar[XB_XGEN(b.x)]) == gen, bar);
            __builtin_amdgcn_fence(__ATOMIC_ACQUIRE, "agent");
            asm volatile("s_waitcnt vmcnt(0)" ::: "memory");
        }
    }
    __syncthreads();
}

#ifndef REP_ATT
#define REP_ATT 1
#endif
#ifndef REP_BL
#define REP_BL 1
#endif
#ifndef REP_SMP
#define REP_SMP 1
#endif
#ifndef REP_BO
#define REP_BO 1
#endif
#ifndef REP_CO
#define REP_CO 1
#endif
#ifndef REP_MRG
#define REP_MRG 1
#endif
#ifndef REP_P4
#define REP_P4 1
#endif
#ifndef REP_P6
#define REP_P6 1
#endif
#ifndef REP_G1
#define REP_G1 1
#endif
#ifndef REP_P0
#define REP_P0 1
#endif
#ifndef REP_G3
#define REP_G3 1
#endif
#ifndef REP_SCANPROBE
#define REP_SCANPROBE 1
#endif
#ifndef EN_ATT
#define EN_ATT 1
#endif
#ifndef EN_BL
#define EN_BL 1
#endif
#ifndef EN_CL
#define EN_CL 1
#endif
#ifndef EN_BO
#define EN_BO 1
#endif
#ifndef EN_CO
#define EN_CO 1
#endif
#ifndef EN_EPIPROJ
#define EN_EPIPROJ 1
#endif
#ifndef EN_EPIACT
#define EN_EPIACT 1
#endif
#ifndef EN_EPISTASH
#define EN_EPISTASH 1
#endif
#ifndef EN_EPIPLE
#define EN_EPIPLE 1
#endif
#ifndef EN_EPIRES
#define EN_EPIRES 1
#endif


__device__ __forceinline__ int owave(int w) { asm volatile("" : "+s"(w)); return __builtin_amdgcn_readfirstlane(w); }
__device__ __forceinline__ int olane() { int t = (int)__builtin_amdgcn_mbcnt_hi(~0u, __builtin_amdgcn_mbcnt_lo(~0u, 0u)); asm volatile("" : "+v"(t)); return t; }
typedef const Args __attribute__((address_space(4)))* KArgP;
__device__ __forceinline__ KArgP kargs_ptr() { KArgP p = (KArgP)__builtin_amdgcn_kernarg_segment_ptr(); asm volatile("" : "+s"(p)); return p; }
__global__ void __launch_bounds__(NTHR, 2) mega_fwd(Args args) {
    extern __shared__ __attribute__((aligned(16))) unsigned char smem[];
    cg::grid_group grid = cg::this_grid();
    const int wv0 = __builtin_amdgcn_readfirstlane((int)threadIdx.x >> 6);
    __builtin_assume(gridDim.x <= 1024u); __builtin_assume(blockIdx.x < gridDim.x);
#define tid  (owave(wv0) * 64 + olane())
#define lane (olane())
#define wave (owave(wv0))
#define G    ((int)gridDim.x)
#define bid  ((int)blockIdx.x)
#define gw   (bid * NWAVES + wave)
#define NGW  (G * NWAVES)
#define gt   (bid * NTHR + tid)
#define NGT  (G * NTHR)
#define KWS_EARLY (kargs_ptr()->ws)
    {
        volatile LAS unsigned* st0 = (volatile LAS unsigned*)((LAS unsigned char*)smem + 131072 + 256);
        if (threadIdx.x < 2) st0[threadIdx.x] = 0u;
        __syncthreads();
        (void)xcd_barrier_post((unsigned*)(KWS_EARLY + WS_BAR), st0, threadIdx.x == 0);
    }
#define GSYNC() do { XcdBarrier b_; b_.bar = (unsigned*)(KWS + WS_BAR); b_.x = xb_xcc_id(); b_.st = (volatile LAS unsigned*)((LAS unsigned char*)smem + 131072 + 256); xcd_barrier(b_, wv0 == 0 && olane() == 0); } while (0)
#define ldsg ((PG8_LAS unsigned char*)smem)
#define part0 ((float*)smem)
#define part1 (part0 + PART_FLOATS)
#define KIN(i) (kargs_ptr()->in[i])
#define KWS    (kargs_ptr()->ws)
#define KOUT   (kargs_ptr()->out)
#define H      (KOUT + O_YP)
#define HS     (KOUT + O_YS)
#define HB0    ((bf16_t*)(KWS + WS_HB0))
#define HB1    ((bf16_t*)(KWS + WS_HB1))
#define ACT    ((bf16_t*)(KWS + WS_ACT))
#define QB     ((bf16_t*)(KWS + WS_QB))
#define KB     ((bf16_t*)(KWS + WS_KB))
#define VB     ((bf16_t*)(KWS + WS_VB))
#define ZF     ((float*)(KWS + WS_ZF))
#define OC     ((bf16_t*)(KWS + WS_OC))
#define LSE    ((float*)(KWS + WS_LSE))
#define MIX    ((bf16_t*)(KWS + WS_MIX))
#define PB     ((bf16_t*)(KWS + WS_PB))
#define UB     ((float*)(KWS + WS_UB))
#define UC     ((float*)(KWS + WS_UC))
#define AB     ((float*)(KWS + WS_AB))
#define AC     ((float*)(KWS + WS_AC))
#define SSQ0   ((float*)(KWS + WS_SSQ0))
#define SSQ1   ((float*)(KWS + WS_SSQ1))
#define PP     ((float*)(KWS + WS_PP))
#define LB     ((float*)(KWS + WS_LB))
#define HSB0   ((bf16_t*)(KWS + WS_HSB0))
#define HSB1   ((bf16_t*)(KWS + WS_HSB1))
#define ACTS   ((bf16_t*)(KWS + WS_ACTS))
#define ZS     ((float*)(KWS + WS_ZS))
#define MIXS   ((bf16_t*)(KWS + WS_MIXS))
#define PSB    ((bf16_t*)(KWS + WS_PSB))
#define SSQS0  ((float*)(KWS + WS_SSQS0))
#define SSQS1  ((float*)(KWS + WS_SSQS1))
#define WLP(l, off) (KWS + WS_W + (size_t)(l) * WL_SIZE + (off))

    {
        float* scr = (float*)(smem + wave * 16384);
        constexpr int I_GU = 16 * 88, I_DN = 44 * 32, I_IN = 16 * 121, I_SQ = 16 * 32, I_PP = 4 * 32;
        constexpr int PER_L = 2 * I_GU + I_DN + I_IN + I_SQ + 2 * I_GU + I_DN + I_SQ + I_PP;
        for (int it = gw; it < 2 * PER_L; it += NGW) {
            const int l = it / PER_L; int r = it % PER_L;
            unsigned char* wl = WLP(l, 0);
            if (r < I_GU) { tr_item(KIN(9) + (size_t)l * DM * FF, DM, FF, KIN(8) + l * DM, (bf16_t*)(wl + WL_W1GU), 1, scr, r, lane); continue; } r -= I_GU;
            if (r < I_GU) { tr_item(KIN(10) + (size_t)l * DM * FF, DM, FF, KIN(8) + l * DM, (bf16_t*)(wl + WL_W1GU), 2, scr, r, lane); continue; } r -= I_GU;
            if (r < I_DN) { tr_item(KIN(11) + (size_t)l * FF * DM, FF, DM, nullptr, (bf16_t*)(wl + WL_W1D), 0, scr, r, lane); continue; } r -= I_DN;
            if (r < I_IN) { tr_item(KIN(13) + (size_t)l * DM * PW, DM, PW, KIN(12) + l * DM, (bf16_t*)(wl + WL_WIN), 3, scr, r, lane); continue; } r -= I_IN;
            if (r < I_SQ) { tr_item(KIN(19) + (size_t)l * DM * DM, DM, DM, nullptr, (bf16_t*)(wl + WL_WOUT), 0, scr, r, lane); continue; } r -= I_SQ;
            if (r < I_GU) { tr_item(KIN(21) + (size_t)l * DM * FF, DM, FF, KIN(20) + l * DM, (bf16_t*)(wl + WL_W2GU), 1, scr, r, lane); continue; } r -= I_GU;
            if (r < I_GU) { tr_item(KIN(22) + (size_t)l * DM * FF, DM, FF, KIN(20) + l * DM, (bf16_t*)(wl + WL_W2GU), 2, scr, r, lane); continue; } r -= I_GU;
            if (r < I_DN) { tr_item(KIN(23) + (size_t)l * FF * DM, FF, DM, nullptr, (bf16_t*)(wl + WL_W2D), 0, scr, r, lane); continue; } r -= I_DN;
            if (r < I_SQ) { tr_item(KIN(25) + (size_t)l * DM * DM, DM, DM, KIN(24) + l * DM, (bf16_t*)(wl + WL_WPG), 0, scr, r, lane); continue; } r -= I_SQ;
            tr_item(KIN(26) + (size_t)l * 256 * DM, 256, DM, nullptr, (bf16_t*)(wl + WL_WPP), 0, scr, r, lane);
        }
        for (int i = gt; i < 2 * 30720; i += NGT) { const int l = i / 30720, j = i % 30720;
            *(u32x4*)(WLP(l, WL_WIN) + (size_t)PW * DM * 2 + (size_t)j * 16) = (u32x4){0u, 0u, 0u, 0u}; }
        for (int row = gw; row < T + NS; row += NGW) {
            const bool smp = row >= T; const int rr = smp ? row - T : row;
            const float* xr = (smp ? KIN(1) : KIN(0)) + (size_t)rr * DM;
            float* hr = (smp ? HS : H) + (size_t)rr * DM; bf16_t* br = (smp ? HSB0 : HB0) + (size_t)rr * DM;
            float s = 0.f; f32x4 xv[4];
#pragma unroll
            for (int j = 0; j < 4; ++j) xv[j] = *(const f32x4*)(xr + 256 * j + 4 * lane);
#pragma unroll
            for (int j = 0; j < 4; ++j) { const f32x4 v = xv[j]; if (smp) *(f32x4*)(hr + 256 * j + 4 * lane) = v;
                u32x2 w; w.x = cvt_pk_bf16(v[0], v[1]); w.y = cvt_pk_bf16(v[2], v[3]); *(u32x2*)(br + 256 * j + 4 * lane) = w;
                s += (v[0] * v[0] + v[1] * v[1]) + (v[2] * v[2] + v[3] * v[3]); }
            s = wave_sum(s);
            if (smp) { if (lane < 32) SSQS0[rr * 32 + lane] = (lane == 0) ? s : 0.f; }
            else     { if (lane < 16) SSQ0[(size_t)rr * 16 + lane] = (lane == 0) ? s : 0.f; }
        }
        for (int i0 = gt; i0 < 2 * T * 256 / 8; i0 += 4 * NGT) { f32x4 pa[4], pb[4];
#pragma unroll
            for (int q = 0; q < 4; ++q) { const int i = i0 + q * NGT; const float* p = KIN(6) + (size_t)(i < 2 * T * 256 / 8 ? i : i0) * 8; pa[q] = *(const f32x4*)p; pb[q] = *(const f32x4*)(p + 4); }
#pragma unroll
            for (int q = 0; q < 4; ++q) { const int i = i0 + q * NGT; if (i < 2 * T * 256 / 8) *(u32x4*)(PB + (size_t)i * 8) = pg8::pack8(pa[q], pb[q]); } }
        for (int i = gt; i < 2 * NS * 256 / 8; i += NGT) { const float* p = KIN(7) + (size_t)i * 8; const f32x4 a = *(const f32x4*)p, b = *(const f32x4*)(p + 4); *(u32x4*)(PSB + (size_t)i * 8) = pg8::pack8(a, b); }
        if (gt < 512) { const float l0 = KIN(14)[gt], l1 = KIN(14)[512 + gt], m = fmaxf(l0, l1), e0 = __expf(l0 - m), e1 = __expf(l1 - m), s0 = e0 / (e0 + e1), s1 = e1 / (e0 + e1);
            LB[gt] = fmaxf(s0 - s0, 0.f); LB[512 + gt] = fmaxf((s0 + s1) - s0, 0.f); }
    }
    if (KWS == nullptr) grid.sync();
    GSYNC();

    for (int l = 0; l < 2; ++l) {
#define W1GU ((const bf16_t*)WLP(l, WL_W1GU))
#define W1D  ((const bf16_t*)WLP(l, WL_W1D))
#define WIN  ((const bf16_t*)WLP(l, WL_WIN))
#define WOUT ((const bf16_t*)WLP(l, WL_WOUT))
#define W2GU ((const bf16_t*)WLP(l, WL_W2GU))
#define W2D  ((const bf16_t*)WLP(l, WL_W2D))
#define WPG  ((const bf16_t*)WLP(l, WL_WPG))
#define WPP  ((const bf16_t*)WLP(l, WL_WPP))
#define WGU ((const bf16_t*)WLP(l, ffn ? WL_W2GU : WL_W1GU))
#define WD  ((const bf16_t*)WLP(l, ffn ? WL_W2D : WL_W1D))
#define lbl   (LB + l * 512)
#define bnorm (KIN(15) + l * 256)
#define cwg   (KIN(16) + l * 16 * 128)
#define cbias (KIN(17) + l * 128)
#define cnorm (KIN(18) + l * 256)
        for (int ffn = 0; ffn < 2; ++ffn) {
            if (ffn == 1) {
                {
                    pg8::Gemm g{HB1, WIN, T, NPAD, DM}; pg8::StaticOrder S; S.init(T, NPAD, G, bid);
                    pg8::EpiProj E{KWS, KOUT, l, WS_SSQ1, WS_QB, WS_KB, WS_VB, WS_ZF, O_KAP, O_VAP};

#if EN_EPIPROJ
pg8::gemm_phase<pg8::EpiProj, pg8::StaticOrder, true, true>(ldsg, g, S, E, wv0);
#endif

                    __syncthreads();
                    for (int tile = bid; tile < 121; tile += G) {
                        sgemm_tile(HSB1, WIN, DM, 32 * tile, part0, wave, lane);
                        __syncthreads();
                        { const int row = tid >> 4, c0 = (tid & 15) * 2; const float r = row_rinv32(SSQS1, row);
                          ZS[(size_t)row * NPAD + 32 * tile + c0] = part_sum(part0, row, c0) * r; ZS[(size_t)row * NPAD + 32 * tile + c0 + 1] = part_sum(part0, row, c0 + 1) * r; }
                        __syncthreads();
                    }
                }
                GSYNC();
                {

#if EN_ATT
                    {
                        if (wave >= 4) { for (int task = (wave - 4) * G + bid; task < NCH * 4; task += 4 * G) c_task<false>(ZF, (float*)(KWS + WS_FCB), cwg, cbias, UC, AC, cnorm, MIX, task >> 2, task & 3, (float*)(smem + wave * 14336), lane); }
                        const int q = (3 * 8 * 512) / NGW, rm = (3 * 8 * 512) % NGW, g = gw;
                        if (G == 256) attn_units(KWS, bid * 48 + (wave < 4 ? wave * 7 : 28 + (wave - 4) * 5), wave < 4 ? 7 : 5, smem + wave * 14336, lane);
                        else attn_units(KWS, g * q + (g < rm ? g : rm), q + (g < rm ? 1 : 0), smem + wave * 14336, lane);
                    }
#endif

                    __syncthreads();

#if EN_BL
{ int task = bid; do { b_local(ZF, lbl, UB, AB, task >> 2, task & 3, smem, tid, wave, lane); task += G; } while (task < NCHB * 4); }
#endif


#if EN_CL
;
#endif

                    __syncthreads();
                    for (int task = bid; task < 512; task += G) {
                        if (task < 256) s_attn(ZS, KIN(2) + (size_t)l * NS * 2048 * 512, KIN(3) + (size_t)l * NS * 2048 * 512, MIXS, KOUT + O_KAS + (size_t)l * NS * 512, KOUT + O_VAS + (size_t)l * NS * 512,
                                               task >> 3, task & 7, smem, tid, wave, lane);
                        else if (task < 384) s_b(ZS, KIN(4) + (size_t)l * NS * 32768, KOUT + O_SBS + (size_t)l * NS * 32768, lbl, bnorm, MIXS, (task - 256) >> 2, (task - 256) & 3, smem, tid, wave, lane);
                        else s_c(ZS, KIN(5) + (size_t)l * NS * 8192, KOUT + O_SCS + (size_t)l * NS * 8192, cwg, cbias, cnorm, MIXS, (task - 384) >> 2, (task - 384) & 3, smem, tid, wave, lane);
                    }
                }
                GSYNC();
                {
                    float* gA = (float*)smem; float* gU = gA + 8 * 64;
                    for (int task = bid; task < 640; task += G) {
                        const int e = task * 64 + lane; const bool isb = task < 512; const int ee = isb ? e : e - 32768;
                        float* U = isb ? UB : UC; const float* A = isb ? AB : AC; const int usz = isb ? 32768 : 8192, asz = isb ? 512 : 128;
                        const int g = wave, ak = ee >> 6; const bool act = !isb || g < NCHB / 32;
                        float u[32], a[32];
#pragma unroll
                        for (int i = 0; i < 32; ++i) { u[i] = 0.f; a[i] = 1.f; }
                        if (act) {
#pragma unroll
                            for (int i = 0; i < 32; ++i) { u[i] = U[(size_t)(32 * g + i) * usz + ee]; a[i] = A[(size_t)(32 * g + i) * asz + ak]; }
                        }
                        float sl = 0.f, c = 1.f;
#pragma unroll
                        for (int i = 0; i < 32; ++i) { const float ui = u[i], ai = a[i]; u[i] = sl; a[i] = c; sl = ai * sl + ui; c *= ai; }
                        gA[g * 64 + lane] = c; gU[g * 64 + lane] = sl;
                        __syncthreads();
                        float carry = 0.f;
                        for (int j = 0; j < g; ++j) carry = gA[j * 64 + lane] * carry + gU[j * 64 + lane];
#pragma unroll
                        for (int i = 0; i < 32; ++i) { if (act) U[(size_t)(32 * g + i) * usz + ee] = a[i] * carry + u[i]; }
                        if (g == 7) (isb ? KOUT + O_SBP + (size_t)l * 32768 : KOUT + O_SCP + (size_t)l * 8192)[ee] = c * carry + sl;
                        __syncthreads();
                    }
                }
                GSYNC();
                {

#if EN_BO
{ int task = bid; do { b_output(ZF, lbl, UB, bnorm, MIX, task >> 2, task & 3, smem, tid, wave, lane); task += G; } while (task < NCHB * 4); }
#endif


#if EN_CO
if (wave < 4 || G != 256) for (int task = wave * G + bid; task < NCH * 4; task += NGW) c_task<true>(ZF, (float*)(KWS + WS_FCB), cwg, cbias, UC, AC, cnorm, MIX, task >> 2, task & 3, (float*)(smem + wave * 14336), lane);
#endif

                    const bool mrg_half = (G == 256);
                    if (!mrg_half || wave >= 4) {
                        const int istr = mrg_half ? G * 256 : NGT;
                        for (int i0 = mrg_half ? bid * 256 + (tid - 256) : gt; i0 < T * 64; i0 += 4 * istr) {
                            float lw[4][3]; u32x4 va[4], vb[4], vc[4];
#pragma unroll
                            for (int q = 0; q < 4; ++q) { const int i = i0 + q * istr; const bool ok = i < T * 64; const int ii = ok ? i : i0;
                                const int t = ii >> 6, h = (ii >> 3) & 7, d8 = ii & 7; const size_t off = (size_t)t * 512 + h * 64 + d8 * 8;
                                lw[q][0] = LSE[((size_t)0 * T + t) * 8 + h]; lw[q][1] = LSE[((size_t)1 * T + t) * 8 + h]; lw[q][2] = LSE[((size_t)2 * T + t) * 8 + h];
                                va[q] = *(const u32x4*)(OC + off); vb[q] = *(const u32x4*)(OC + (size_t)T * 512 + off); vc[q] = *(const u32x4*)(OC + (size_t)2 * T * 512 + off); }
#pragma unroll
                            for (int q = 0; q < 4; ++q) { const int i = i0 + q * istr; if (i < T * 64) {
                                const int t = i >> 6, h = (i >> 3) & 7, d8 = i & 7;
                                const float l0 = lw[q][0], l1 = lw[q][1], l2 = lw[q][2];
                                const float m = fmaxf(l0, fmaxf(l1, l2)); float w0 = __expf(l0 - m), w1 = __expf(l1 - m), w2 = __expf(l2 - m); const float inv = 1.0f / (w0 + w1 + w2); w0 *= inv; w1 *= inv; w2 *= inv;
                                const u32x4 a = va[q], b = vb[q], c = vc[q];
                                u32x4 o;
#pragma unroll
                                for (int j = 0; j < 4; ++j) {
                                    const float lo = w0 * __uint_as_float(a[j] << 16) + w1 * __uint_as_float(b[j] << 16) + w2 * __uint_as_float(c[j] << 16);
                                    const float hi = w0 * __uint_as_float(a[j] & 0xffff0000u) + w1 * __uint_as_float(b[j] & 0xffff0000u) + w2 * __uint_as_float(c[j] & 0xffff0000u);
                                    o[j] = cvt_pk_bf16(lo, hi);
                                }
                                *(u32x4*)(MIX + (size_t)t * 1024 + h * 64 + d8 * 8) = o; } }
                        }
                    }
                }
                GSYNC();
                {
                    pg8::Gemm g{MIX, WOUT, T, DM, DM}; pg8::StaticOrder S; S.init(T, DM, G, bid);
                    pg8::EpiRes E{H, H, HB0, SSQ0, 1.0f};

#if EN_EPIRES
pg8::gemm_phase<pg8::EpiRes, pg8::StaticOrder, true, true>(ldsg, g, S, E, wv0);
#endif

                    __syncthreads();
                    for (int tile = bid; tile < 32; tile += G) {
                        sgemm_tile(MIXS, WOUT, DM, 32 * tile, part0, wave, lane);
                        __syncthreads();
                        { const int row = tid >> 4, c0 = (tid & 15) * 2; float* hp = HS + (size_t)row * DM + 32 * tile + c0;
                          const float h0 = hp[0] + part_sum(part0, row, c0), h1 = hp[1] + part_sum(part0, row, c0 + 1); hp[0] = h0; hp[1] = h1;
                          *(unsigned*)(HSB0 + (size_t)row * DM + 32 * tile + c0) = cvt_pk_bf16(h0, h1);
                          float ss = h0 * h0 + h1 * h1;
#pragma unroll
                          for (int o = 1; o < 16; o <<= 1) ss += __shfl_xor(ss, o);
                          if ((tid & 15) == 0) SSQS0[row * 32 + tile] = ss; }
                        __syncthreads();
                    }
                }
                GSYNC();
            }

            {
                pg8::Gemm g{HB0, WGU, T, 2 * FF, DM}; pg8::StaticOrder S; S.init(T, 2 * FF, G, bid);
                pg8::EpiAct E{SSQ0, ACT};

#if EN_EPIACT
pg8::gemm_phase<pg8::EpiAct, pg8::StaticOrder, true, true>(ldsg, g, S, E, wv0);
#endif

                __syncthreads();
                if (ffn == 1) {
                    pg8::Gemm g2{PB + (size_t)l * T * 256, WPP, T, DM, 256}; pg8::HalfOrder S2; S2.init(G, bid);
                    pg8::EpiStash E2{PP};
                    pg8::gemm_phase<pg8::EpiStash, pg8::HalfOrder, true, true>(ldsg, g2, S2, E2, wv0);
                    __syncthreads();
                }

                for (int pt = (G == 256) ? (bid >= 128 ? bid - 128 : 1 << 20) : bid; pt < 88; pt += G) {
                    const int n0 = 256 * (pt >> 2) + 32 * (pt & 3);
                    sgemm_tile(HSB0, WGU, DM, n0, part0, wave, lane);
                    sgemm_tile(HSB0, WGU, DM, n0 + 128, part1, wave, lane);
                    __syncthreads();
                    { const int row = tid >> 4, c0 = (tid & 15) * 2; const float r = row_rinv32(SSQS0, row);
                      const float g0 = part_sum(part0, row, c0) * r, g1 = part_sum(part0, row, c0 + 1) * r, u0 = part_sum(part1, row, c0) * r, u1 = part_sum(part1, row, c0 + 1) * r;
                      *(unsigned*)(ACTS + (size_t)row * FF + 32 * pt + c0) = cvt_pk_bf16(fsilu(g0) * u0, fsilu(g1) * u1); }
                    __syncthreads();
                }
            }
            GSYNC();
            {
                pg8::Gemm g{ACT, WD, T, DM, FF}; pg8::StaticOrder S; S.init(T, DM, G, bid);
                pg8::EpiRes E{(l == 0 && ffn == 0) ? KIN(0) : (const float*)H, H, HB1, SSQ1, 0.5f};

#if EN_EPIRES
pg8::gemm_phase<pg8::EpiRes, pg8::StaticOrder, true, true>(ldsg, g, S, E, wv0);
#endif

                __syncthreads();
                for (int tile = bid; tile < 32; tile += G) {
                    sgemm_tile(ACTS, WD, FF, 32 * tile, part0, wave, lane);
                    __syncthreads();
                    { const int row = tid >> 4, c0 = (tid & 15) * 2; float* hp = HS + (size_t)row * DM + 32 * tile + c0;
                      const float h0 = hp[0] + 0.5f * part_sum(part0, row, c0), h1 = hp[1] + 0.5f * part_sum(part0, row, c0 + 1); hp[0] = h0; hp[1] = h1;
                      *(unsigned*)(HSB1 + (size_t)row * DM + 32 * tile + c0) = cvt_pk_bf16(h0, h1);
                      float ss = h0 * h0 + h1 * h1;
#pragma unroll
                      for (int o = 1; o < 16; o <<= 1) ss += __shfl_xor(ss, o);
                      if ((tid & 15) == 0) SSQS1[row * 32 + tile] = ss; }
                    __syncthreads();
                }
            }
            GSYNC();
        }
        {
            { pg8::Gemm g{HB1, WPG, T, DM, DM}; pg8::StaticOrder S; S.init(T, DM, G, bid);
              pg8::EpiPle E{SSQ1, PP, H, HB0, SSQ0};

#if EN_EPIPLE
pg8::gemm_phase<pg8::EpiPle, pg8::StaticOrder, true, true>(ldsg, g, S, E, wv0);
#endif
 }
            __syncthreads();
            for (int tile = bid; tile < 32; tile += G) {
                sgemm_tile(PSB + (size_t)l * NS * 256, WPP, 256, 32 * tile, part0, wave, lane);
                sgemm_tile(HSB1, WPG, DM, 32 * tile, part1, wave, lane);
                __syncthreads();
                { const int row = tid >> 4, c0 = (tid & 15) * 2; float* hp = HS + (size_t)row * DM + 32 * tile + c0; const float r = row_rinv32(SSQS1, row);
                  const float h0 = hp[0] + fsigmoid(part_sum(part1, row, c0) * r) * part_sum(part0, row, c0), h1 = hp[1] + fsigmoid(part_sum(part1, row, c0 + 1) * r) * part_sum(part0, row, c0 + 1);
                  hp[0] = h0; hp[1] = h1;
                  *(unsigned*)(HSB0 + (size_t)row * DM + 32 * tile + c0) = cvt_pk_bf16(h0, h1);
                  float ss = h0 * h0 + h1 * h1;
#pragma unroll
                  for (int o = 1; o < 16; o <<= 1) ss += __shfl_xor(ss, o);
                  if ((tid & 15) == 0) SSQS0[row * 32 + tile] = ss; }
                __syncthreads();
            }
        }
        GSYNC();
    }
    {
        f32x4 gv[4];
#pragma unroll
        for (int j = 0; j < 4; ++j) gv[j] = *(const f32x4*)(KIN(27) + 256 * j + 4 * lane);
        for (int row0 = gw; row0 < T + NS; row0 += 4 * NGW) {
            f32x4 v[4][4]; float r[4];
#pragma unroll
            for (int q = 0; q < 4; ++q) { const int row = row0 + q * NGW; const bool ok = row < T + NS; const int rw = ok ? row : row0;
                const bool smp = rw >= T; const int rr = smp ? rw - T : rw;
                const float* hr = (smp ? HS : H) + (size_t)rr * DM;
#pragma unroll
                for (int j = 0; j < 4; ++j) v[q][j] = *(const f32x4*)(hr + 256 * j + 4 * lane);
                r[q] = smp ? row_rinv32(SSQS0, rr) : pg8::row_rinv16(SSQ0, rr); }
#pragma unroll
            for (int q = 0; q < 4; ++q) { const int row = row0 + q * NGW; if (row < T + NS) {
                const bool smp = row >= T; const int rr = smp ? row - T : row;
                float* hr = (smp ? HS : H) + (size_t)rr * DM;
#pragma unroll
                for (int j = 0; j < 4; ++j) *(f32x4*)(hr + 256 * j + 4 * lane) = v[q][j] * r[q] * gv[j]; } }
        }
    }
}

extern "C" void kernel_launch(void* const* d_in, const int* in_sizes, int n_in, void* d_out, int out_size, void* d_ws, size_t ws_size, hipStream_t stream) {
    static int grid = 0;
    if (grid == 0) {
        if (n_in != 28 || (size_t)out_size != O_END || ws_size < WS_END) { fprintf(stderr, "kernel_launch: unexpected shapes (n_in %d out %d ws %zu need %zu)\n", n_in, out_size, ws_size, (size_t)WS_END); grid = -1; return; }
        int dev = 0, cus = 0, per_cu = 0;
        if (hipGetDevice(&dev) != hipSuccess || hipDeviceGetAttribute(&cus, hipDeviceAttributeMultiprocessorCount, dev) != hipSuccess) { grid = -1; return; }
        if (hipFuncSetAttribute((const void*)mega_fwd, hipFuncAttributeMaxDynamicSharedMemorySize, LDS_BYTES) != hipSuccess) { fprintf(stderr, "kernel_launch: hipFuncSetAttribute failed\n"); grid = -1; return; }
        if (hipOccupancyMaxActiveBlocksPerMultiprocessor(&per_cu, (const void*)mega_fwd, NTHR, LDS_BYTES) != hipSuccess || per_cu < 1) { fprintf(stderr, "kernel_launch: occupancy query failed (%d)\n", per_cu); (void)hipGetLastError(); per_cu = 1; }
        grid = cus * 1;
        if (grid > cus * per_cu) grid = cus * per_cu;
    }
    if (grid < 0) return;
    if (hipMemsetAsync((unsigned char*)d_ws + WS_BAR, 0, WS_BAR_BYTES, stream) != hipSuccess) { fprintf(stderr, "kernel_launch: memset failed\n"); return; }
    Args a{};
    for (int i = 0; i < 28; ++i) a.in[i] = (const float*)d_in[i];
    a.out = (float*)d_out; a.ws = (unsigned char*)d_ws;
    void* kargs[] = {&a};
    hipError_t e = hipLaunchCooperativeKernel((const void*)mega_fwd, dim3(grid), dim3(NTHR), kargs, LDS_BYTES, stream);
    if (e != hipSuccess) fprintf(stderr, "kernel_launch: cooperative launch failed: %s (grid %d)\n", hipGetErrorString(e), grid);
}
```
